# Optimizing an MI355X kernel written in HIP

```python
import math
import numpy as np
import jax
import jax.numpy as jnp
from jax import lax

D_MODEL = 2048
BATCH = 2
SEQ = 16384
DEPTH = 1
DEC_BATCH = 8
DEC_SEQ = 32
PAST_LEN = 4096

CHUNK = 64
Q_BLOCK = 128
EPS = 1e-6

N_HEADS = 16
HEAD_DIM = 64
N_KV_HEADS = 4
GROUP = N_HEADS // N_KV_HEADS
IDX_HEADS = 16
IDX_DIM = 64
TOPK_MAX = 256
N_BUCKETS = 32
MAX_DISTANCE = 128

REC_HEADS = 8
REC_DK = 128
REC_DV = 128

D_FF = 5632

ATTN_WIDTH = N_HEADS * HEAD_DIM
KV_WIDTH = N_KV_HEADS * HEAD_DIM
REC_K_WIDTH = REC_HEADS * REC_DK
REC_V_WIDTH = REC_HEADS * REC_DV
IN_WIDTHS = (ATTN_WIDTH, KV_WIDTH, KV_WIDTH, IDX_HEADS * IDX_DIM, IDX_DIM, IDX_HEADS,
             REC_K_WIDTH, REC_K_WIDTH, REC_V_WIDTH, REC_V_WIDTH, D_MODEL, D_MODEL)
IN_SPLITS = tuple(int(s) for s in np.cumsum(IN_WIDTHS)[:-1])
IN_TOTAL = int(sum(IN_WIDTHS))

kernel_name = 'hybrid_stream_dsa_hgrn2_macaron'


def rmsnorm(x, g):
    xf = x.astype(jnp.float32)
    y = xf * lax.rsqrt(jnp.mean(xf * xf, axis=-1, keepdims=True) + EPS)
    return (y * g.astype(jnp.float32)).astype(x.dtype)


def swiglu_half(x, norm_g, w_in, w_out):
    h = rmsnorm(x, norm_g)
    gate, up = jnp.split(h @ w_in, 2, axis=-1)
    return 0.5 * ((jax.nn.silu(gate) * up) @ w_out)


def t5_bucket(rel):
    half = N_BUCKETS // 2
    max_exact = half // 2
    n = jnp.abs(rel)
    large = max_exact + (jnp.log(jnp.maximum(n, max_exact).astype(jnp.float32) / max_exact)
                         / math.log(MAX_DISTANCE / max_exact) * (half - max_exact)).astype(jnp.int32)
    large = jnp.minimum(large, half - 1)
    return jnp.where(rel > 0, half, 0) + jnp.where(n < max_exact, n, large)


def sparse_attend(q, qi, wi, q_pos, k, v, ki, rel_bias, topk):
    B, Tq = q.shape[0], q.shape[1]
    L = k.shape[1]
    limit = (q_pos // CHUNK + 1) * CHUNK
    visible = jnp.arange(L, dtype=jnp.int32)[None, :] < limit[:, None]
    dots = jnp.einsum('bqhd,bsd->bqhs', qi.astype(jnp.float32), ki.astype(jnp.float32))
    score = jnp.einsum('bqhs,bqh->bqs', jax.nn.relu(dots), wi.astype(jnp.float32))
    score = jnp.where(visible[None], score, -jnp.inf)
    top_val, idx = lax.top_k(score, topk)
    valid = top_val > -jnp.inf
    gather = jax.vmap(lambda rows, sel: rows[sel])
    k_sel = gather(k, idx)
    v_sel = gather(v, idx)
    bias = rel_bias[t5_bucket(idx - q_pos[None, :, None])].astype(jnp.float32)
    bias = bias.reshape(B, Tq, topk, N_KV_HEADS, GROUP).transpose(0, 1, 3, 4, 2)
    qg = q.reshape(B, Tq, N_KV_HEADS, GROUP, HEAD_DIM)
    logits = jnp.einsum('bqngd,bqknd->bqngk', qg, k_sel).astype(jnp.float32) * (HEAD_DIM ** -0.5) + bias
    logits = jnp.where(valid[:, :, None, None, :], logits, -jnp.inf)
    p = jax.nn.softmax(logits, axis=-1).astype(v.dtype)
    o = jnp.einsum('bqngk,bqknd->bqngd', p, v_sel)
    return o.reshape(B, Tq, ATTN_WIDTH)


def sparse_attention(q, qi, wi, q_pos, k, v, ki, rel_bias, topk):
    B, T = q.shape[0], q.shape[1]
    blk = min(Q_BLOCK, T)
    nb = T // blk

    def split(a):
        return a.reshape((B, nb, blk) + a.shape[2:]).swapaxes(0, 1)

    def one(args):
        qb, qib, wib, pb = args
        return sparse_attend(qb, qib, wib, pb, k, v, ki, rel_bias, topk)

    o = lax.map(one, (split(q), split(qi), split(wi), q_pos.reshape(nb, blk)))
    return o.swapaxes(0, 1).reshape(B, T, ATTN_WIDTH)


def hgrn2_recurrence(q, k, v, logf, s0):
    B, T = q.shape[0], q.shape[1]
    C = min(CHUNK, T)
    n = T // C

    def chunks(a):
        return a.reshape(B, n, C, REC_HEADS, a.shape[-1]).transpose(1, 0, 3, 2, 4)

    causal = jnp.tril(jnp.ones((C, C), dtype=bool))[:, :, None]

    def step(S, inp):
        qc, kc, vc, gc = inp
        b = jnp.cumsum(gc, axis=2)
        diff = b[:, :, :, None, :] - b[:, :, None, :, :]
        decay = jnp.exp(jnp.where(causal, diff, -jnp.inf))
        scores = jnp.einsum('bhtk,bhsk,bhtsk->bhts', qc, kc, decay)
        o = (jnp.einsum('bhtk,bhkv->bhtv', qc * jnp.exp(b), S)
             + jnp.einsum('bhts,bhsv->bhtv', scores, vc))
        b_end = b[:, :, -1:, :]
        S = (jnp.exp(b_end[:, :, 0, :])[..., None] * S
             + jnp.einsum('bhsk,bhsv->bhkv', kc * jnp.exp(b_end - b), vc))
        return S, o

    S, o = lax.scan(step, s0, (chunks(q), chunks(k), chunks(v), chunks(logf)))
    return o.transpose(1, 0, 3, 2, 4).reshape(B, T, REC_HEADS, REC_DV), S


def token_mixer(h, past_k, past_v, past_ki, s0, lb, w_in, g_q, g_k, rel_bias, g_rec,
                w_attn, w_rec, w_out, topk):
    B, T = h.shape[0], h.shape[1]
    P = past_k.shape[1]
    q, k, v, qi, ki, wi, rf, rq, ri, rg, ga, gb = jnp.split(h @ w_in, IN_SPLITS, axis=-1)
    q = rmsnorm(q.reshape(B, T, N_HEADS, HEAD_DIM), g_q)
    k = rmsnorm(k.reshape(B, T, N_KV_HEADS, HEAD_DIM), g_k)
    v = v.reshape(B, T, N_KV_HEADS, HEAD_DIM)
    qi = qi.reshape(B, T, IDX_HEADS, IDX_DIM)
    wi = wi * (IDX_HEADS ** -0.5)
    q_pos = P + jnp.arange(T, dtype=jnp.int32)
    k_all = jnp.concatenate([past_k.astype(k.dtype), k], axis=1)
    v_all = jnp.concatenate([past_v.astype(v.dtype), v], axis=1)
    ki_all = jnp.concatenate([past_ki.astype(ki.dtype), ki], axis=1)
    o_attn = sparse_attention(q, qi, wi, q_pos, k_all, v_all, ki_all, rel_bias, topk)
    fgate = lb + (1.0 - lb) * jax.nn.sigmoid(rf.astype(jnp.float32))
    shp_k = (B, T, REC_HEADS, REC_DK)
    logf = jnp.log(fgate).reshape(shp_k)
    kk = (1.0 - fgate).reshape(shp_k)
    qq = jax.nn.silu(rq.astype(jnp.float32)).reshape(shp_k)
    vv = ri.astype(jnp.float32).reshape(B, T, REC_HEADS, REC_DV)
    o_rec, S = hgrn2_recurrence(qq, kk, vv, logf, s0.astype(jnp.float32))
    o_rec = rmsnorm(o_rec, g_rec).reshape(B, T, REC_V_WIDTH) * jax.nn.silu(rg.astype(jnp.float32))
    o_rec = o_rec.astype(h.dtype)
    merged = jax.nn.sigmoid(ga) * (o_attn @ w_attn) + jax.nn.sigmoid(gb) * (o_rec @ w_rec)
    return merged @ w_out, k, v, ki, S.astype(s0.dtype)


def trunk(x, past_k, past_v, past_ki, s0, topk, lower_bounds, norm_ffa, w_ffa_in, w_ffa_out,
          norm_mix, w_in, qk_gain_q, qk_gain_k, rel_bias, hgrn_norm, w_branch_attn,
          w_branch_rec, w_out, norm_ffb, w_ffb_in, w_ffb_out):
    ks, vs, kis, ss = [], [], [], []
    for l in range(DEPTH):
        x = x + swiglu_half(x, norm_ffa[l], w_ffa_in[l], w_ffa_out[l])
        mix, k, v, ki, S = token_mixer(rmsnorm(x, norm_mix[l]), past_k[l], past_v[l], past_ki[l], s0[l],
                                       lower_bounds[l], w_in[l], qk_gain_q[l], qk_gain_k[l], rel_bias,
                                       hgrn_norm[l], w_branch_attn[l], w_branch_rec[l], w_out[l], topk)
        x = x + mix
        x = x + swiglu_half(x, norm_ffb[l], w_ffb_in[l], w_ffb_out[l])
        ks.append(k)
        vs.append(v)
        kis.append(ki)
        ss.append(S)
    return x, jnp.stack(ks), jnp.stack(vs), jnp.stack(kis), jnp.stack(ss)


def setup_inputs(seed: int = 0) -> dict:
    key = jax.random.key(seed)
    kk = jax.random.split(key, 24)

    def nrm(k, shape, scale=1.0):
        return jax.random.normal(k, shape, jnp.float32) * scale

    def gain(k, shape):
        return 1.0 + 0.05 * jax.random.normal(k, shape, jnp.float32)

    return {
        'x_prompt': nrm(kk[0], (BATCH, SEQ, D_MODEL)),
        'x_sample': nrm(kk[1], (DEC_BATCH, DEC_SEQ, D_MODEL)),
        'cache_k': nrm(kk[2], (DEPTH, DEC_BATCH, PAST_LEN, N_KV_HEADS, HEAD_DIM)),
        'cache_v': nrm(kk[3], (DEPTH, DEC_BATCH, PAST_LEN, N_KV_HEADS, HEAD_DIM)),
        'cache_kidx': nrm(kk[4], (DEPTH, DEC_BATCH, PAST_LEN, IDX_DIM)),
        'state_hgrn': nrm(kk[5], (DEPTH, DEC_BATCH, REC_HEADS, REC_DK, REC_DV), 0.3),
        'norm_ffa': gain(kk[6], (DEPTH, D_MODEL)),
        'w_ffa_in': nrm(kk[7], (DEPTH, D_MODEL, 2 * D_FF), D_MODEL ** -0.5),
        'w_ffa_out': nrm(kk[8], (DEPTH, D_FF, D_MODEL), D_FF ** -0.5),
        'norm_mix': gain(kk[9], (DEPTH, D_MODEL)),
        'w_in': nrm(kk[10], (DEPTH, D_MODEL, IN_TOTAL), D_MODEL ** -0.5),
        'qk_gain_q': gain(kk[11], (DEPTH, HEAD_DIM)),
        'qk_gain_k': gain(kk[12], (DEPTH, HEAD_DIM)),
        'rel_bias': nrm(kk[13], (N_BUCKETS, N_HEADS), 0.5),
        'hgrn_lb_raw': nrm(kk[14], (DEPTH + 1, REC_K_WIDTH)),
        'hgrn_norm': gain(kk[15], (DEPTH, REC_DV)),
        'w_branch_attn': nrm(kk[16], (DEPTH, ATTN_WIDTH, D_MODEL), ATTN_WIDTH ** -0.5),
        'w_branch_rec': nrm(kk[17], (DEPTH, REC_V_WIDTH, D_MODEL), REC_V_WIDTH ** -0.5),
        'w_out': nrm(kk[18], (DEPTH, D_MODEL, D_MODEL), D_MODEL ** -0.5),
        'norm_ffb': gain(kk[19], (DEPTH, D_MODEL)),
        'w_ffb_in': nrm(kk[20], (DEPTH, D_MODEL, 2 * D_FF), D_MODEL ** -0.5),
        'w_ffb_out': nrm(kk[21], (DEPTH, D_FF, D_MODEL), D_FF ** -0.5),
    }


def reference(x_prompt, x_sample, cache_k, cache_v, cache_kidx, state_hgrn, norm_ffa, w_ffa_in,
              w_ffa_out, norm_mix, w_in, qk_gain_q, qk_gain_k, rel_bias, hgrn_lb_raw, hgrn_norm,
              w_branch_attn, w_branch_rec, w_out, norm_ffb, w_ffb_in, w_ffb_out):
    lb_p = jax.nn.softmax(hgrn_lb_raw.astype(jnp.float32), axis=0)
    lower_bounds = jnp.cumsum(lb_p, axis=0)[:DEPTH]
    Bp, Tp = x_prompt.shape[0], x_prompt.shape[1]
    topk_prompt = min(TOPK_MAX, Tp // 4)
    topk_sample = min(TOPK_MAX, (cache_k.shape[2] + x_sample.shape[1]) // 4)
    dt = x_prompt.dtype
    empty_k = jnp.zeros((DEPTH, Bp, 0, N_KV_HEADS, HEAD_DIM), dt)
    empty_ki = jnp.zeros((DEPTH, Bp, 0, IDX_DIM), dt)
    zero_s = jnp.zeros((DEPTH, Bp, REC_HEADS, REC_DK, REC_DV), state_hgrn.dtype)
    weights = (norm_ffa, w_ffa_in, w_ffa_out, norm_mix, w_in, qk_gain_q, qk_gain_k, rel_bias, hgrn_norm,
               w_branch_attn, w_branch_rec, w_out, norm_ffb, w_ffb_in, w_ffb_out)
    y_prompt, k_prompt, v_prompt, kidx_prompt, hgrn_prompt = trunk(
        x_prompt, empty_k, empty_k, empty_ki, zero_s, topk_prompt, lower_bounds, *weights)
    y_sample, k_sample, v_sample, kidx_sample, hgrn_sample = trunk(
        x_sample, cache_k, cache_v, cache_kidx, state_hgrn, topk_sample, lower_bounds, *weights)
    return (y_prompt, y_sample, k_prompt, v_prompt, kidx_prompt, hgrn_prompt,
            k_sample, v_sample, kidx_sample, hgrn_sample)
```

```cpp
#include <hip/hip_runtime.h>
#include <hip/hip_cooperative_groups.h>
#include <cstdio>
#include <cstdint>
namespace cg = cooperative_groups;

#define LAS __attribute__((address_space(3)))
typedef unsigned short bf16_t;
typedef short bf16x8 __attribute__((ext_vector_type(8)));
typedef float f32x4 __attribute__((ext_vector_type(4)));
typedef float f32x16 __attribute__((ext_vector_type(16)));
typedef unsigned u32x4 __attribute__((ext_vector_type(4)));
typedef unsigned u32x2 __attribute__((ext_vector_type(2)));

constexpr int DM = 2048, MP = 32768, MS = 256, MT = MP + MS, DFF = 5632, NFF = 2 * DFF, NPROJ = 11008;
constexpr int SEQ = 16384, DSEQ = 32, PAST = 4096, LS = PAST + DSEQ;
constexpr float EPS = 1e-6f;
constexpr int C_Q = 0, C_K = 1024, C_V = 1280, C_QI = 1536, C_RF = 2560, C_RQ = 3584, C_RI = 4608, C_RG = 5632, C_GA = 6656, C_GB = 8704, C_KI = 10752, C_WI = 10816;
constexpr size_t O_Y = 0, O_KP = 67633152, O_VP = 76021760, O_KIP = 84410368, O_HP = 86507520, O_KS = 86769664, O_VS = 86835200, O_KIS = 86900736, O_HS = 86917120;
constexpr size_t MiB = 1u << 20;
constexpr size_t WS_A = 1 * MiB, WS_B = 45 * MiB, WS_WATT = 67 * MiB, WS_WREC = 71 * MiB, WS_WOUT = 75 * MiB, WS_H = 83 * MiB, WS_BIG = 212 * MiB,
                 WS_IDX = 906 * MiB, WS_CK = 923 * MiB, WS_CV = 939 * MiB, WS_CKI = 955 * MiB, WS_SST = 959 * MiB, WS_SDL = 961 * MiB, WS_HD = 963 * MiB, WS_END = 966 * MiB;
constexpr int LDS_BYTES = 147456;
constexpr int NPH = 15;

struct Params {
    const float* in[22];
    float* out;
    unsigned char* ws;
    int ph_lo, ph_hi;
};

__device__ __forceinline__ unsigned f2bf(float f) { unsigned u = __builtin_bit_cast(unsigned, f); return (u + 0x7fffu + ((u >> 16) & 1u)) >> 16; }
typedef float f32x2_t __attribute__((ext_vector_type(2)));
typedef __bf16 bf16x2_t __attribute__((ext_vector_type(2)));
__device__ __forceinline__ unsigned pk2(float lo, float hi) { f32x2_t v = {lo, hi}; bf16x2_t b = __builtin_convertvector(v, bf16x2_t); return __builtin_bit_cast(unsigned, b); }
__device__ __forceinline__ float bf2f(unsigned h) { return __builtin_bit_cast(float, h << 16); }
__device__ __forceinline__ float bflo(unsigned w) { return __builtin_bit_cast(float, w << 16); }
__device__ __forceinline__ float bfhi(unsigned w) { return __builtin_bit_cast(float, w & 0xffff0000u); }
__device__ __forceinline__ float sigmoidf_(float x) { return __builtin_amdgcn_rcpf(1.f + __expf(-x)); }
__device__ __forceinline__ float siluf_(float x) { return x * sigmoidf_(x); }
__device__ __forceinline__ float wave_sum(float v) {
#pragma unroll
    for (int o = 1; o < 64; o <<= 1) v += __shfl_xor(v, o);
    return v;
}
#define LDS_WAIT() asm volatile("s_waitcnt lgkmcnt(0)" ::: "memory")

namespace pg8 {
#define PG8_LAS __attribute__((address_space(3)))
constexpr int BM = 256, BK = 64, HALF = 128, HTB = HALF * BK * 2, STAGE_BYTES = 8 * HTB, NXCD = 8, WGM = 8;
__host__ __device__ __forceinline__ int lds_byte(int r, int c) { const int st = (r >> 4) * 2 + (c >> 5), rr = r & 15, cc = c & 31, ob = rr * 64 + cc * 2; return st * 1024 + (ob ^ (((ob >> 9) & 1) << 5)); }
__host__ __device__ __forceinline__ void stage_rc(int b, int& R, int& C) { const int st = b / 1024, sb = b % 1024, swz = sb ^ (((sb >> 9) & 1) << 5); R = (st >> 1) * 16 + swz / 64; C = (st & 1) * 32 + (swz % 64) / 2; }
__host__ __device__ __forceinline__ int perm32(int rho) { const int n = rho >> 4, i = rho & 15; return 8 * (i >> 2) + 4 * n + (i & 3); }
struct Unit { int pm, pn; };
struct Gemm { const bf16_t* A; const bf16_t* Bt; int M, N, K, lda; };
struct StaticOrder {
    int nM, nN, nwg, G, c;
    __host__ __device__ void init(int M, int N, int G_, int c_) { nM = M / BM; nN = N / BM; nwg = nM * nN; G = G_; c = c_; }
    __host__ __device__ bool next(int i, Unit& u) const {
        const long L = (long)i * G + c; if (L >= nwg) return false;
        int wgid = (int)L; { const int q = nwg / NXCD, r = nwg % NXCD, xcd = wgid % NXCD, off = wgid / NXCD; wgid = (xcd < r ? xcd * (q + 1) : r * (q + 1) + (xcd - r) * q) + off; }
        const int nig = WGM * nN, gid = wgid / nig, fm = gid * WGM, gsz = (nM - fm) < WGM ? (nM - fm) : WGM;
        u.pm = fm + ((wgid % nig) % gsz); u.pn = (wgid % nig) / gsz; return true;
    }
    __device__ __forceinline__ void a_ready(const Unit&) const {}
    __device__ __forceinline__ void done(const Unit&) const {}
};

enum { EPI_SWIGLU = 0, EPI_RESID = 1, EPI_PROJ = 2, EPI_MERGE1 = 3, EPI_MERGE2 = 4 };
template <int MODE> struct Epi {
    static constexpr bool PERM = true, AFTER_DRAIN = false;
    bf16_t* O; float* Y; const float* R0; const float* R1; float alpha;
    __device__ __forceinline__ void operator()(const f32x4 (&acc)[2][2][4][2], const Unit& u, int wr, int wc, int fr, int fq) const {
        const int row0 = u.pm * BM + wr * 64 + fr;
        if constexpr (MODE == EPI_SWIGLU) {
            const int col0 = u.pn * 128 + wc * 32 + 8 * fq;
#pragma unroll
            for (int ai = 0; ai < 2; ++ai)
#pragma unroll
                for (int m = 0; m < 4; ++m) {
                    const int row = row0 + ai * HALF + m * 16;
                    float h[8];
#pragma unroll
                    for (int n = 0; n < 2; ++n)
#pragma unroll
                        for (int j = 0; j < 4; ++j) { const float g = acc[ai][0][m][n][j], up = acc[ai][1][m][n][j]; h[4 * n + j] = siluf_(g) * up; }
                    u32x4 w; w.x = pk2(h[0], h[1]); w.y = pk2(h[2], h[3]); w.z = pk2(h[4], h[5]); w.w = pk2(h[6], h[7]);
                    *(u32x4*)(O + (size_t)row * DFF + col0) = w;
                }
        } else if constexpr (MODE == EPI_RESID) {
#pragma unroll
            for (int ai = 0; ai < 2; ++ai)
#pragma unroll
                for (int m = 0; m < 4; ++m) {
                    const int row = row0 + ai * HALF + m * 16;
                    const float* rp = (row < MP) ? R0 + (size_t)row * DM : R1 + (size_t)(row - MP) * DM;
                    float* yp = Y + (size_t)row * DM;
#pragma unroll
                    for (int bj = 0; bj < 2; ++bj) {
                        const int col = u.pn * BM + bj * HALF + wc * 32 + 8 * fq;
                        const f32x4 r0 = *(const f32x4*)(rp + col), r1 = *(const f32x4*)(rp + col + 4);
                        *(f32x4*)(yp + col) = r0 + acc[ai][bj][m][0] * alpha;
                        *(f32x4*)(yp + col + 4) = r1 + acc[ai][bj][m][1] * alpha;
                    }
                }
        } else {
            const bool sig = (MODE == EPI_PROJ) && (u.pn >= C_GA / 256) && (u.pn < C_KI / 256);
#pragma unroll
            for (int ai = 0; ai < 2; ++ai)
#pragma unroll
                for (int m = 0; m < 4; ++m) {
                    const int row = row0 + ai * HALF + m * 16;
#pragma unroll
                    for (int bj = 0; bj < 2; ++bj) {
                        const int col = u.pn * BM + bj * HALF + wc * 32 + 8 * fq;
                        float v[8];
#pragma unroll
                        for (int n = 0; n < 2; ++n)
#pragma unroll
                            for (int j = 0; j < 4; ++j) v[4 * n + j] = acc[ai][bj][m][n][j];
                        bf16_t* op;
                        if constexpr (MODE == EPI_PROJ) {
                            op = O + (size_t)row * NPROJ + col;
                            if (sig) {
#pragma unroll
                                for (int e = 0; e < 8; ++e) v[e] = sigmoidf_(v[e]);
                            }
                        } else {
                            op = O + (size_t)row * NPROJ + C_GA + col;
                            const u32x4 g = *(const u32x4*)op;
                            const float gv[8] = {bflo(g.x), bfhi(g.x), bflo(g.y), bfhi(g.y), bflo(g.z), bfhi(g.z), bflo(g.w), bfhi(g.w)};
                            if constexpr (MODE == EPI_MERGE1) {
#pragma unroll
                                for (int e = 0; e < 8; ++e) v[e] = gv[e] * v[e];
                            } else {
                                const u32x4 g2 = *(const u32x4*)(op + (C_GB - C_GA));
                                const float hv[8] = {bflo(g2.x), bfhi(g2.x), bflo(g2.y), bfhi(g2.y), bflo(g2.z), bfhi(g2.z), bflo(g2.w), bfhi(g2.w)};
#pragma unroll
                                for (int e = 0; e < 8; ++e) v[e] = gv[e] + hv[e] * v[e];
                            }
                        }
                        u32x4 w; w.x = pk2(v[0], v[1]); w.y = pk2(v[2], v[3]); w.z = pk2(v[4], v[5]); w.w = pk2(v[6], v[7]);
                        *(u32x4*)op = w;
                    }
                }
        }
    }
};

template <class Epi, class Sched, bool ALIGN_EPI = false, bool SP2 = false>
__device__ __forceinline__ void gemm_phase(PG8_LAS unsigned char* lds, const Gemm g, const Sched& S, const Epi& E) {
    const int tid = threadIdx.x, wid = __builtin_amdgcn_readfirstlane(tid >> 6), lane = tid & 63, wr = wid >> 2, wc = wid & 3, fr = lane & 15, fq = lane >> 4;
    const int K = g.K, nt = K / BK;
    unsigned voffA[2], voffB[2];
#pragma unroll
    for (int i = 0; i < 2; ++i) { int R, C; stage_rc(tid * 16 + i * 8192, R, C); const int Rb = Epi::PERM ? ((R & ~31) + perm32(R & 31)) : R;
        voffA[i] = (unsigned)(R * g.lda + C) * 2u; voffB[i] = (unsigned)(Rb * K + C) * 2u; }
    const size_t kstep = (size_t)(BK * 2);
    const size_t hstepB = (size_t)HALF * K * 2, hstepA = (size_t)HALF * g.lda * 2;
    const size_t tstepA = 2 * hstepA, tstepB = 2 * hstepB;
    const unsigned ldsw = (unsigned)wid * 1024u;
    const int aoff = lds_byte(wr * 64 + fr, fq * 8), boff = lds_byte(wc * 32 + fr, fq * 8);
#define PG8_SA(b, h) (((b) * 2 + (h)) * HTB)
#define PG8_SB(b, h) ((4 + (b) * 2 + (h)) * HTB)
#define PG8_STAGE(bufoff, gbase, voff) do { _Pragma("unroll") for (int _i = 0; _i < 2; ++_i) \
        __builtin_amdgcn_global_load_lds((const unsigned*)((const char*)(gbase) + (voff)[_i]), (PG8_LAS unsigned*)(lds + (bufoff) + ldsw + _i * 8192), 16, 0, 0); } while (0)
#define PG8_LDA(dst, b, h) do { _Pragma("unroll") for (int m = 0; m < 4; ++m) _Pragma("unroll") for (int k = 0; k < 2; ++k) dst[m][k] = *(const PG8_LAS bf16x8*)(lds + PG8_SA(b, h) + aoff + m * 2048 + k * 1024); } while (0)
#define PG8_LDB(dst, b, h) do { _Pragma("unroll") for (int n = 0; n < 2; ++n) _Pragma("unroll") for (int k = 0; k < 2; ++k) dst[n][k] = *(const PG8_LAS bf16x8*)(lds + PG8_SB(b, h) + boff + n * 2048 + k * 1024); } while (0)
#define PG8_MMA(ai, bj, At, Bt) do { __builtin_amdgcn_s_setprio(1); _Pragma("unroll") for (int m = 0; m < 4; ++m) _Pragma("unroll") for (int n = 0; n < 2; ++n) _Pragma("unroll") for (int k = 0; k < 2; ++k) \
        acc[ai][bj][m][n] = __builtin_amdgcn_mfma_f32_16x16x32_bf16(Bt[n][k], At[m][k], acc[ai][bj][m][n], 0, 0, 0); __builtin_amdgcn_s_setprio(0); } while (0)
#define PG8_WAIT_V(n) asm volatile("s_waitcnt vmcnt(" #n ")" ::: "memory")
#define PG8_WAIT_L(n) asm volatile("s_waitcnt lgkmcnt(" #n ")" ::: "memory")
#define PG8_BAR __builtin_amdgcn_s_barrier()
#define PG8_SCHED __builtin_amdgcn_sched_barrier(0)
    Unit cur, nxt; int ui = 0;
    if (!S.next(0, cur)) return;
    f32x4 acc[2][2][4][2];
#pragma unroll
    for (int a = 0; a < 2; ++a)
#pragma unroll
        for (int b = 0; b < 2; ++b)
#pragma unroll
            for (int m = 0; m < 4; ++m)
#pragma unroll
                for (int n = 0; n < 2; ++n) acc[a][b][m][n] = (f32x4){0.f, 0.f, 0.f, 0.f};
    bf16x8 At[4][2], B0[2][2], B1[2][2];
    const char* cA = (const char*)g.A + (size_t)cur.pm * tstepA; const char* cB = (const char*)g.Bt + (size_t)cur.pn * tstepB;
    S.a_ready(cur);
    if constexpr (SP2) {
        PG8_STAGE(PG8_SB(0, 0), cB, voffB); PG8_STAGE(PG8_SB(0, 1), cB + hstepB, voffB); PG8_STAGE(PG8_SA(0, 0), cA, voffA); PG8_STAGE(PG8_SA(0, 1), cA + hstepA, voffA);
        if (wr == 1) PG8_BAR;
        PG8_WAIT_V(2); PG8_BAR;
        PG8_STAGE(PG8_SB(1, 0), cB + kstep, voffB); PG8_STAGE(PG8_SA(1, 0), cA + kstep, voffA); PG8_STAGE(PG8_SB(1, 1), cB + hstepB + kstep, voffB);
        PG8_WAIT_V(6); PG8_BAR;
    } else {
        PG8_STAGE(PG8_SB(0, 0), cB, voffB); PG8_STAGE(PG8_SA(0, 0), cA, voffA); PG8_STAGE(PG8_SB(0, 1), cB + hstepB, voffB); PG8_STAGE(PG8_SA(0, 1), cA + hstepA, voffA);
        if (wr == 1) PG8_BAR;
        PG8_WAIT_V(4); PG8_BAR;
        PG8_STAGE(PG8_SB(1, 0), cB + kstep, voffB); PG8_STAGE(PG8_SA(1, 0), cA + kstep, voffA); PG8_STAGE(PG8_SB(1, 1), cB + hstepB + kstep, voffB);
        PG8_WAIT_V(6); PG8_BAR;
    }
    for (;;) {
        const bool has_next = S.next(ui + 1, nxt);
        const char* nA = has_next ? (const char*)g.A + (size_t)nxt.pm * tstepA : cA; const char* nB = has_next ? (const char*)g.Bt + (size_t)nxt.pn * tstepB : cB;
        for (int t = 0; t < nt; t += 2) {
            const bool last = (t == nt - 2);
            const char* a1 = cA + (size_t)(t + 1) * kstep;
            const char* a2 = last ? nA : cA + (size_t)(t + 2) * kstep; const char* b2 = last ? nB : cB + (size_t)(t + 2) * kstep;
            const char* a3 = a2 + kstep; const char* b3 = b2 + kstep;
            if (last && has_next) S.a_ready(nxt);
            if constexpr (SP2) {
            PG8_LDB(B0, 0, 0); PG8_LDB(B1, 0, 1); PG8_SCHED; PG8_LDA(At, 0, 0); PG8_STAGE(PG8_SA(1, 1), a1 + hstepA, voffA);
            PG8_WAIT_V(8); PG8_WAIT_L(0); PG8_BAR; PG8_MMA(0, 0, At, B0); PG8_MMA(0, 1, At, B1); PG8_BAR; PG8_SCHED;
            PG8_LDA(At, 0, 1); PG8_STAGE(PG8_SB(0, 0), b2, voffB); PG8_STAGE(PG8_SB(0, 1), b2 + hstepB, voffB); PG8_STAGE(PG8_SA(0, 0), a2, voffA);
            PG8_WAIT_V(8); PG8_WAIT_L(0); PG8_BAR; PG8_MMA(1, 0, At, B0); PG8_MMA(1, 1, At, B1); PG8_BAR; PG8_SCHED;
            PG8_LDB(B0, 1, 0); PG8_LDB(B1, 1, 1); PG8_SCHED; PG8_LDA(At, 1, 0); PG8_STAGE(PG8_SA(0, 1), a2 + hstepA, voffA);
            PG8_WAIT_V(8); PG8_WAIT_L(0); PG8_BAR; PG8_MMA(0, 0, At, B0); PG8_MMA(0, 1, At, B1); PG8_BAR; PG8_SCHED;
            PG8_LDA(At, 1, 1); PG8_STAGE(PG8_SB(1, 0), b3, voffB); PG8_STAGE(PG8_SB(1, 1), b3 + hstepB, voffB); PG8_STAGE(PG8_SA(1, 0), a3, voffA);
            PG8_WAIT_V(8); PG8_WAIT_L(0); PG8_BAR; PG8_MMA(1, 0, At, B0); PG8_MMA(1, 1, At, B1); PG8_BAR; PG8_SCHED;
            } else {
            PG8_LDB(B0, 0, 0); PG8_SCHED; PG8_LDA(At, 0, 0); PG8_STAGE(PG8_SA(1, 1), a1 + hstepA, voffA);
            PG8_WAIT_L(8); PG8_BAR; PG8_WAIT_L(0); PG8_MMA(0, 0, At, B0); PG8_BAR; PG8_SCHED;
            PG8_LDB(B1, 0, 1); PG8_STAGE(PG8_SB(0, 0), b2, voffB);
            PG8_BAR; PG8_WAIT_L(0); PG8_MMA(0, 1, At, B1); PG8_BAR;
            PG8_LDA(At, 0, 1); PG8_STAGE(PG8_SA(0, 0), a2, voffA);
            PG8_BAR; PG8_WAIT_L(0); PG8_MMA(1, 0, At, B0); PG8_BAR; PG8_SCHED;
            PG8_STAGE(PG8_SB(0, 1), b2 + hstepB, voffB);
            PG8_WAIT_V(6); PG8_BAR; PG8_MMA(1, 1, At, B1); PG8_BAR;
            PG8_LDB(B0, 1, 0); PG8_SCHED; PG8_LDA(At, 1, 0); PG8_STAGE(PG8_SA(0, 1), a2 + hstepA, voffA);
            PG8_WAIT_L(8); PG8_BAR; PG8_WAIT_L(0); PG8_MMA(0, 0, At, B0); PG8_BAR; PG8_SCHED;
            PG8_LDB(B1, 1, 1); PG8_STAGE(PG8_SB(1, 0), b3, voffB);
            PG8_BAR; PG8_WAIT_L(0); PG8_MMA(0, 1, At, B1); PG8_BAR;
            PG8_LDA(At, 1, 1); PG8_STAGE(PG8_SA(1, 0), a3, voffA);
            PG8_BAR; PG8_WAIT_L(0); PG8_MMA(1, 0, At, B0); PG8_BAR; PG8_SCHED;
            PG8_STAGE(PG8_SB(1, 1), b3 + hstepB, voffB);
            PG8_WAIT_V(6); PG8_BAR; PG8_MMA(1, 1, At, B1); PG8_BAR;
            }
        }
        if constexpr (ALIGN_EPI) { if (wr == 0) PG8_BAR; }
        if constexpr (!Epi::AFTER_DRAIN) { E(acc, cur, wr, wc, fr, fq); S.done(cur); }
        if (!has_next) break;
#pragma unroll
        for (int a = 0; a < 2; ++a)
#pragma unroll
            for (int b = 0; b < 2; ++b)
#pragma unroll
                for (int m = 0; m < 4; ++m)
#pragma unroll
                    for (int n = 0; n < 2; ++n) acc[a][b][m][n] = (f32x4){0.f, 0.f, 0.f, 0.f};
        cur = nxt; cA = nA; cB = nB; ++ui;
        if constexpr (ALIGN_EPI) { if (wr == 1) PG8_BAR; }
    }
    PG8_WAIT_V(0);
    if constexpr (!ALIGN_EPI) { if (wr == 0) PG8_BAR; }
    PG8_BAR;
    if constexpr (Epi::AFTER_DRAIN) { E.fused(acc, cur, wr, wc, fr, fq, lds, wid, lane); S.done(cur); }
#undef PG8_SA
#undef PG8_SB
#undef PG8_STAGE
#undef PG8_LDA
#undef PG8_LDB
#undef PG8_MMA
#undef PG8_WAIT_V
#undef PG8_WAIT_L
#undef PG8_BAR
#undef PG8_SCHED
}
}

struct Ctx {
    LAS unsigned char* lds;
    int tid, lane, wave, G, bid;
};

template <int MAP> __device__ __forceinline__ int wmap(int c) {
    if constexpr (MAP == 1) { return c < DFF ? (256 * (c >> 7) + (c & 127)) : (256 * ((c - DFF) >> 7) + 128 + ((c - DFF) & 127)); }
    else if constexpr (MAP == 2) { return c < 2560 ? c : (c < 2624 ? C_KI + (c - 2560) : (c < 2640 ? C_WI + (c - 2624) : c - 80)); }
    else return c;
}
template <int MAP> __device__ __forceinline__ void transpose_tile(const Ctx& X, const float* W, int K, int N, bf16_t* WT, int item) {
    LAS float* scr = (LAS float*)X.lds;
    const int nblk = (N + 63) / 64, kb = item / nblk, nb = item % nblk, k0 = 64 * kb, n0 = 64 * nb;
    const int j = X.tid & 63, i0 = X.tid >> 6;
    __syncthreads();
#pragma unroll
    for (int r = 0; r < 8; ++r) { const int i = i0 + 8 * r; scr[i * 65 + j] = (n0 + j < N) ? W[(size_t)(k0 + i) * N + n0 + j] : 0.f; }
    __syncthreads();
    const int c = X.tid & 7, n = X.tid >> 3;
    if (n0 + n < N) {
        const LAS float* s = scr + (8 * c) * 65 + n;
        u32x4 o; o.x = pk2(s[0], s[65]); o.y = pk2(s[2 * 65], s[3 * 65]); o.z = pk2(s[4 * 65], s[5 * 65]); o.w = pk2(s[6 * 65], s[7 * 65]);
        *(u32x4*)(WT + (size_t)wmap<MAP>(n0 + n) * K + k0 + 8 * c) = o;
    }
}
template <int MAP> __device__ __forceinline__ void convert_weight(const Ctx& X, const float* W, int K, int N, bf16_t* WT) {
    const int nitems = (K / 64) * ((N + 63) / 64);
    for (int it = X.bid; it < nitems; it += X.G) transpose_tile<MAP>(X, W, K, N, WT, it);
    __syncthreads();
}

__device__ __forceinline__ void rmsnorm_rows(const Ctx& X, const float* r0, const float* r1, const float* g, bf16_t* H) {
    const int gw = X.bid * 8 + X.wave, NGW = X.G * 8;
    f32x4 gv[8];
#pragma unroll
    for (int j = 0; j < 8; ++j) gv[j] = *(const f32x4*)(g + 4 * (64 * j + X.lane));
    for (int m = gw; m < MT; m += NGW) {
        const float* xr = (m < MP) ? r0 + (size_t)m * DM : r1 + (size_t)(m - MP) * DM;
        f32x4 v[8]; float s = 0.f;
#pragma unroll
        for (int j = 0; j < 8; ++j) { v[j] = *(const f32x4*)(xr + 4 * (64 * j + X.lane)); s += (v[j].x * v[j].x + v[j].y * v[j].y) + (v[j].z * v[j].z + v[j].w * v[j].w); }
        const float rs = 1.f / sqrtf(wave_sum(s) * (1.f / DM) + EPS);
        bf16_t* o = H + (size_t)m * DM;
#pragma unroll
        for (int j = 0; j < 8; ++j) { u32x2 w; w.x = pk2(v[j].x * rs * gv[j].x, v[j].y * rs * gv[j].y); w.y = pk2(v[j].z * rs * gv[j].z, v[j].w * rs * gv[j].w); *(u32x2*)(o + 4 * (64 * j + X.lane)) = w; }
    }
}

__device__ __forceinline__ void convert_flat(const Ctx& X, const float* src, bf16_t* dst, size_t n) {
    const size_t nthr = (size_t)X.G * 512;
    for (size_t i = ((size_t)X.bid * 512 + X.tid) * 8; i < n; i += nthr * 8) {
        const f32x4 a = *(const f32x4*)(src + i), b = *(const f32x4*)(src + i + 4);
        u32x4 w; w.x = pk2(a.x, a.y); w.y = pk2(a.z, a.w); w.z = pk2(b.x, b.y); w.w = pk2(b.z, b.w);
        *(u32x4*)(dst + i) = w;
    }
}

__device__ __forceinline__ void postproj_rows(const Ctx& X, const Params& p, bf16_t* PROJ) {
    const int gw = X.bid * 8 + X.wave, NGW = X.G * 8, lane = X.lane;
    const float* gq = p.in[11]; const float* gk = p.in[12];
    float gqv[16], gkv[4];
#pragma unroll
    for (int e = 0; e < 16; ++e) gqv[e] = gq[16 * (lane & 3) + e];
#pragma unroll
    for (int e = 0; e < 4; ++e) gkv[e] = gk[4 * (lane & 15) + e];
    for (int m = gw; m < MT; m += NGW) {
        bf16_t* pr = PROJ + (size_t)m * NPROJ;
        {
            bf16_t* qp = pr + C_Q + 16 * lane;
            const u32x4 a = *(const u32x4*)qp, b = *(const u32x4*)(qp + 8);
            float v[16] = {bflo(a.x), bfhi(a.x), bflo(a.y), bfhi(a.y), bflo(a.z), bfhi(a.z), bflo(a.w), bfhi(a.w), bflo(b.x), bfhi(b.x), bflo(b.y), bfhi(b.y), bflo(b.z), bfhi(b.z), bflo(b.w), bfhi(b.w)};
            float s = 0.f;
#pragma unroll
            for (int e = 0; e < 16; ++e) s += v[e] * v[e];
            s += __shfl_xor(s, 1); s += __shfl_xor(s, 2);
            const float rs = 1.f / sqrtf(s * (1.f / 64) + EPS);
#pragma unroll
            for (int e = 0; e < 16; ++e) v[e] = v[e] * rs * gqv[e];
            u32x4 wa, wb; wa.x = pk2(v[0], v[1]); wa.y = pk2(v[2], v[3]); wa.z = pk2(v[4], v[5]); wa.w = pk2(v[6], v[7]);
            wb.x = pk2(v[8], v[9]); wb.y = pk2(v[10], v[11]); wb.z = pk2(v[12], v[13]); wb.w = pk2(v[14], v[15]);
            *(u32x4*)qp = wa; *(u32x4*)(qp + 8) = wb;
        }
        float* ko = (m < MP) ? p.out + O_KP + (size_t)m * 256 : p.out + O_KS + (size_t)(m - MP) * 256;
        float* vo = (m < MP) ? p.out + O_VP + (size_t)m * 256 : p.out + O_VS + (size_t)(m - MP) * 256;
        float* kio = (m < MP) ? p.out + O_KIP + (size_t)m * 64 : p.out + O_KIS + (size_t)(m - MP) * 64;
        {
            bf16_t* kp = pr + C_K + 4 * lane;
            const u32x2 a = *(const u32x2*)kp;
            float v[4] = {bflo(a.x), bfhi(a.x), bflo(a.y), bfhi(a.y)};
            float s = v[0] * v[0] + v[1] * v[1] + v[2] * v[2] + v[3] * v[3];
            s += __shfl_xor(s, 1); s += __shfl_xor(s, 2); s += __shfl_xor(s, 4); s += __shfl_xor(s, 8);
            const float rs = 1.f / sqrtf(s * (1.f / 64) + EPS);
#pragma unroll
            for (int e = 0; e < 4; ++e) v[e] = v[e] * rs * gkv[e];
            u32x2 w; w.x = pk2(v[0], v[1]); w.y = pk2(v[2], v[3]);
            *(u32x2*)kp = w;
            *(f32x4*)(ko + 4 * lane) = (f32x4){v[0], v[1], v[2], v[3]};
        }
        {
            const u32x2 a = *(const u32x2*)(pr + C_V + 4 * lane);
            *(f32x4*)(vo + 4 * lane) = (f32x4){bflo(a.x), bfhi(a.x), bflo(a.y), bfhi(a.y)};
        }
        kio[lane] = bf2f((unsigned)pr[C_KI + lane]);
    }
}

struct SeqInfo { int samp, bs, t, P, nvis, rowbase; };
__device__ __forceinline__ SeqInfo seq_of_row(int m) {
    SeqInfo s;
    if (m < MP) { s.samp = 0; s.bs = m / SEQ; s.t = m % SEQ; s.P = 0; s.nvis = (s.t / 64 + 1) * 64; s.rowbase = s.bs * SEQ; }
    else { s.samp = 1; s.bs = (m - MP) / DSEQ; s.t = (m - MP) % DSEQ; s.P = PAST; s.nvis = LS; s.rowbase = MP + s.bs * DSEQ; }
    return s;
}

constexpr int IX_CAP = 1024;
constexpr int IX_CTL = 131072, IX_BMP = 65536;
__device__ __forceinline__ unsigned ordkey(float f) { const unsigned u = __builtin_bit_cast(unsigned, f); return (u & 0x80000000u) ? ~u : (u | 0x80000000u); }

__device__ __forceinline__ void indexer_item(const Ctx& X, const Params& p, const bf16_t* PROJ, bf16_t* IDX, int item) {
    const int lane = X.lane, wid = X.wave, tid = X.tid;
    const int m0 = item * 8;
    const SeqInfo S = seq_of_row(m0);
    const int nvis = S.nvis, need = nvis < 256 ? nvis : 256, ntiles = nvis / 32;
    const bf16_t* CKI = (const bf16_t*)(p.ws + WS_CKI);
    LAS unsigned* hist = (LAS unsigned*)X.lds;
    LAS unsigned* ctl = (LAS unsigned*)(X.lds + IX_CTL);
    LAS u32x2* cand = (LAS u32x2*)X.lds;
    LAS unsigned* bmp = (LAS unsigned*)(X.lds + IX_BMP);
    __syncthreads();
#pragma unroll
    for (int r = 0; r < 8; ++r) *(LAS u32x4*)(X.lds + (r * 512 + tid) * 16) = (u32x4){0u, 0u, 0u, 0u};
    if (tid < 32) ctl[tid] = 0u;
    { LAS u32x4* bz = (LAS u32x4*)(X.lds + IX_BMP) + 2 * tid; bz[0] = (u32x4){0u, 0u, 0u, 0u}; bz[1] = (u32x4){0u, 0u, 0u, 0u}; }
    { u32x2 z = {0u, 0u}; *(u32x2*)(IDX + (size_t)(m0 + wid) * 256 + 4 * lane) = z; }
    const int rho = lane & 31, hi = lane >> 5, g = rho >> 3, qsel = (rho >> 2) & 1, jj = rho & 3, head = 4 * g + jj;
    bf16x8 af[4][4]; float w[4][16];
#pragma unroll
    for (int a = 0; a < 4; ++a) {
        const bf16_t* qp = PROJ + (size_t)(m0 + 2 * a + qsel) * NPROJ + C_QI + head * 64 + 8 * hi;
#pragma unroll
        for (int kk = 0; kk < 4; ++kk) af[a][kk] = *(const bf16x8*)(qp + 16 * kk);
        const bf16_t* wp = PROJ + (size_t)(m0 + 2 * a + hi) * NPROJ + C_WI;
        const u32x4 w0 = *(const u32x4*)wp, w1 = *(const u32x4*)(wp + 8);
        const float wv[16] = {bflo(w0.x), bfhi(w0.x), bflo(w0.y), bfhi(w0.y), bflo(w0.z), bfhi(w0.z), bflo(w0.w), bfhi(w0.w), bflo(w1.x), bfhi(w1.x), bflo(w1.y), bfhi(w1.y), bflo(w1.z), bfhi(w1.z), bflo(w1.w), bfhi(w1.w)};
#pragma unroll
        for (int i = 0; i < 16; ++i) w[a][i] = wv[i] * 0.25f;
    }
    asm volatile("s_waitcnt vmcnt(0)" ::: "memory");
    __syncthreads();
    for (int pass = 0; pass < 2; ++pass) {
        unsigned thr[4];
        if (pass == 1) {
#pragma unroll
            for (int a = 0; a < 4; ++a) thr[a] = ctl[2 * a + hi];
        }
        for (int kt = wid; kt < ntiles; kt += 8) {
            const int s = kt * 32 + rho;
            const bf16_t* kp;
            if (!S.samp) kp = PROJ + (size_t)(S.rowbase + s) * NPROJ + C_KI;
            else kp = (s < PAST) ? CKI + (size_t)(S.bs * PAST + s) * 64 : PROJ + (size_t)(S.rowbase + s - PAST) * NPROJ + C_KI;
            bf16x8 bfr[4];
#pragma unroll
            for (int kk = 0; kk < 4; ++kk) bfr[kk] = *(const bf16x8*)(kp + 16 * kk + 8 * hi);
#pragma unroll
            for (int a = 0; a < 4; ++a) {
                f32x16 acc = {0, 0, 0, 0, 0, 0, 0, 0, 0, 0, 0, 0, 0, 0, 0, 0};
#pragma unroll
                for (int kk = 0; kk < 4; ++kk) acc = __builtin_amdgcn_mfma_f32_32x32x16_bf16(af[a][kk], bfr[kk], acc, 0, 0, 0);
                float sc = 0.f;
#pragma unroll
                for (int i = 0; i < 16; ++i) sc += w[a][i] * fmaxf(acc[i], 0.f);
                const unsigned key = ordkey(sc), bin = key >> 20;
                const int q = 2 * a + hi;
                if (pass == 0) {
                    atomicAdd((unsigned*)(hist + q * 2048 + (bin >> 1)), (bin & 1) ? 0x10000u : 1u);
                } else {
                    if (bin > thr[a]) {
                        atomicOr((unsigned*)(bmp + q * 512 + (s >> 5)), 1u << (s & 31));
                    } else if (bin == thr[a]) {
                        const unsigned cp = atomicAdd((unsigned*)(ctl + 24 + q), 1u);
                        if (cp < (unsigned)IX_CAP) cand[q * IX_CAP + cp] = (u32x2){key, (unsigned)s};
                    }
                }
            }
        }
        asm volatile("s_waitcnt vmcnt(0) lgkmcnt(0)" ::: "memory");
        __syncthreads();
        if (pass == 0) {
            const LAS unsigned* hq = hist + wid * 2048 + 32 * lane;
            unsigned sum = 0;
            for (int i = 0; i < 32; ++i) { const unsigned c = hq[i]; sum += (c & 0xffffu) + (c >> 16); }
            unsigned suf = sum;
#pragma unroll
            for (int o = 1; o < 64; o <<= 1) { const unsigned t = __shfl_down(suf, o); if (lane + o < 64) suf += t; }
            const unsigned above = suf - sum;
            if (above < (unsigned)need && above + sum >= (unsigned)need) {
                unsigned cum = above; int B = 64 * lane;
                for (int b = 63; b >= 0; --b) {
                    const unsigned c = hq[b >> 1]; const unsigned cnt = (b & 1) ? (c >> 16) : (c & 0xffffu);
                    if (cum + cnt >= (unsigned)need) { B = 64 * lane + b; break; }
                    cum += cnt;
                }
                ctl[wid] = (unsigned)B; ctl[8 + wid] = cum;
            }
            LDS_WAIT();
            __syncthreads();
        }
    }
    {
        const int q = wid;
        const unsigned cab = ctl[8 + q]; unsigned n1 = ctl[24 + q]; if (n1 > (unsigned)IX_CAP) n1 = IX_CAP;
        const int r = need - (int)cab;
        for (unsigned i = lane; i < n1; i += 64) {
            const u32x2 ci = cand[q * IX_CAP + i];
            int rank = 0;
            for (unsigned j = 0; j < n1; ++j) { const u32x2 cj = cand[q * IX_CAP + j]; rank += (cj.x > ci.x || (cj.x == ci.x && cj.y < ci.y)) ? 1 : 0; }
            if (rank < r) atomicOr((unsigned*)(bmp + q * 512 + (ci.y >> 5)), 1u << (ci.y & 31));
        }
        asm volatile("s_waitcnt vmcnt(0) lgkmcnt(0)" ::: "memory");
        __builtin_amdgcn_wave_barrier();
        unsigned wv[8]; unsigned cnt = 0;
#pragma unroll
        for (int i = 0; i < 8; ++i) { wv[i] = bmp[q * 512 + 8 * lane + i]; cnt += __builtin_popcount(wv[i]); }
        unsigned inc = cnt;
#pragma unroll
        for (int o = 1; o < 64; o <<= 1) { const unsigned t = __shfl_up(inc, o); if (lane >= o) inc += t; }
        unsigned pos = inc - cnt;
#pragma unroll
        for (int i = 0; i < 8; ++i) {
            unsigned wq = wv[i];
            while (wq) { const int bpos = __builtin_ctz(wq); wq &= wq - 1; if (pos < 256u) IDX[(size_t)(m0 + q) * 256 + pos] = (bf16_t)((8 * lane + i) * 32 + bpos); ++pos; }
        }
    }
    __syncthreads();
}

constexpr int AT_BIAS = 0, AT_LUT = 2048, AT_WAVE = 4096, AT_WSZ = 5120;
__device__ __forceinline__ void attn_setup(const Ctx& X, const Params& p) {
    LAS float* bl = (LAS float*)(X.lds + AT_BIAS);
    LAS unsigned char* lut = X.lds + AT_LUT;
    __syncthreads();
    if (X.tid < 512) bl[X.tid] = p.in[13][X.tid];
    if (X.tid < 128) { const int n = X.tid; lut[n] = (unsigned char)(n < 8 ? n : n < 12 ? 8 : n < 16 ? 9 : n < 23 ? 10 : n < 32 ? 11 : n < 46 ? 12 : n < 64 ? 13 : n < 91 ? 14 : 15); }
    __syncthreads();
}
__device__ __forceinline__ void attn_query(const Ctx& X, const Params& p, bf16_t* PROJ, const bf16_t* IDX, int m) {
    const int lane = X.lane, hn = lane & 15, lq = lane >> 4;
    const SeqInfo S = seq_of_row(m);
    const int qpos = S.P + S.t, nvalid = S.nvis < 256 ? S.nvis : 256;
    const LAS float* bl = (const LAS float*)(X.lds + AT_BIAS);
    const LAS unsigned char* lut = X.lds + AT_LUT;
    LAS unsigned char* wl = X.lds + AT_WAVE + X.wave * AT_WSZ;
    LAS bf16_t* idl = (LAS bf16_t*)(wl + 4352);
    const bf16_t* CK = (const bf16_t*)(p.ws + WS_CK); const bf16_t* CV = (const bf16_t*)(p.ws + WS_CV);
    { const u32x2 v = *(const u32x2*)(IDX + (size_t)m * 256 + 4 * lane); *(LAS u32x2*)(idl + 4 * lane) = v; }
    bf16x8 qf[2];
    { const bf16_t* qp = PROJ + (size_t)m * NPROJ + C_Q + hn * 64 + 8 * lq; qf[0] = *(const bf16x8*)qp; qf[1] = *(const bf16x8*)(qp + 32); }
    const bf16x8 zero8 = {0, 0, 0, 0, 0, 0, 0, 0};
    const int myn = hn >> 2;
    LDS_WAIT();
    float lg[16][4];
    float mx = -INFINITY;
#pragma unroll
    for (int T = 0; T < 16; ++T) {
        const int s = (int)idl[16 * T + hn];
        const bf16_t* kp;
        if (!S.samp) kp = PROJ + (size_t)(S.rowbase + s) * NPROJ + C_K;
        else kp = (s < PAST) ? CK + (size_t)(S.bs * PAST + s) * 256 : PROJ + (size_t)(S.rowbase + s - PAST) * NPROJ + C_K;
        f32x4 acc = {0.f, 0.f, 0.f, 0.f};
#pragma unroll
        for (int n = 0; n < 4; ++n)
#pragma unroll
            for (int kk = 0; kk < 2; ++kk) {
                const bf16x8 a = *(const bf16x8*)(kp + n * 64 + 32 * kk + 8 * lq);
                const bf16x8 b = (myn == n) ? qf[kk] : zero8;
                acc = __builtin_amdgcn_mfma_f32_16x16x32_bf16(a, b, acc, 0, 0, 0);
            }
#pragma unroll
        for (int i = 0; i < 4; ++i) {
            const int j = 16 * T + 4 * lq + i;
            const int si = (int)idl[j];
            const int rel = si - qpos; int n = rel < 0 ? -rel : rel; n = n > 127 ? 127 : n;
            const int bucket = (rel > 0 ? 16 : 0) + (int)lut[n];
            float v = acc[i] * 0.125f + bl[bucket * 16 + hn];
            v = (j < nvalid) ? v : -INFINITY;
            lg[T][i] = v; mx = fmaxf(mx, v);
        }
    }
    mx = fmaxf(mx, __shfl_xor(mx, 16)); mx = fmaxf(mx, __shfl_xor(mx, 32));
    float sum = 0.f;
#pragma unroll
    for (int T = 0; T < 16; ++T)
#pragma unroll
        for (int i = 0; i < 4; ++i) { const float e = __expf(lg[T][i] - mx); lg[T][i] = e; sum += e; }
    sum += __shfl_xor(sum, 16); sum += __shfl_xor(sum, 32);
    const float inv = 1.f / sum;
    f32x4 O[4];
#pragma unroll
    for (int db = 0; db < 4; ++db) O[db] = (f32x4){0.f, 0.f, 0.f, 0.f};
#pragma unroll
    for (int u = 0; u < 8; ++u) {
        u32x4 pw; pw.x = pk2(lg[2 * u][0] * inv, lg[2 * u][1] * inv); pw.y = pk2(lg[2 * u][2] * inv, lg[2 * u][3] * inv);
        pw.z = pk2(lg[2 * u + 1][0] * inv, lg[2 * u + 1][1] * inv); pw.w = pk2(lg[2 * u + 1][2] * inv, lg[2 * u + 1][3] * inv);
        const bf16x8 pf = __builtin_bit_cast(bf16x8, pw);
        const int r = lane & 31, half = lane >> 5;
        const int s = (int)idl[32 * u + r];
        const bf16_t* vp;
        if (!S.samp) vp = PROJ + (size_t)(S.rowbase + s) * NPROJ + C_V;
        else vp = (s < PAST) ? CV + (size_t)(S.bs * PAST + s) * 256 : PROJ + (size_t)(S.rowbase + s - PAST) * NPROJ + C_V;
#pragma unroll
        for (int n = 0; n < 4; ++n) {
            u32x4 vv[4];
#pragma unroll
            for (int cc = 0; cc < 4; ++cc) vv[cc] = *(const u32x4*)(vp + n * 64 + 8 * (4 * half + cc));
            LDS_WAIT(); __builtin_amdgcn_wave_barrier();
#pragma unroll
            for (int cc = 0; cc < 4; ++cc) *(LAS u32x4*)(wl + r * 136 + 16 * (4 * half + cc)) = vv[cc];
            LDS_WAIT(); __builtin_amdgcn_wave_barrier();
            const bf16x8 pa = (myn == n) ? pf : zero8;
#pragma unroll
            for (int db = 0; db < 4; ++db) {
                bf16x8 vb;
#pragma unroll
                for (int e = 0; e < 8; ++e) { const int rr = (e < 4) ? (4 * lq + e) : (16 + 4 * lq + (e - 4)); vb[e] = (short)*(const LAS bf16_t*)(wl + rr * 136 + 2 * (16 * db + hn)); }
                O[db] = __builtin_amdgcn_mfma_f32_16x16x32_bf16(pa, vb, O[db], 0, 0, 0);
            }
        }
    }
    LDS_WAIT(); __builtin_amdgcn_wave_barrier();
    bf16_t* op = PROJ + (size_t)m * NPROJ + C_Q;
#pragma unroll
    for (int db = 0; db < 4; ++db)
#pragma unroll
        for (int i = 0; i < 4; ++i) op[(4 * lq + i) * 64 + 16 * db + hn] = (bf16_t)f2bf(O[db][i]);
}

constexpr int HG_NP = 4096, HG_NS = 64;
struct HgItem { int samp, sh, c, h, row0, nvalid; };
__device__ __forceinline__ HgItem hg_item(int id) {
    HgItem I;
    if (id < HG_NP) { I.samp = 0; I.sh = id >> 8; I.c = id & 255; I.h = I.sh & 7; I.row0 = (I.sh >> 3) * SEQ + I.c * 64; I.nvalid = 64; }
    else { const int k = id - HG_NP; I.samp = 1; I.sh = k; I.c = 0; I.h = k & 7; I.row0 = MP + (k >> 3) * DSEQ; I.nvalid = 32; }
    return I;
}
__device__ __forceinline__ bf16_t* hg_state_ptr(const Params& p, int id) {
    return (id < HG_NP) ? (bf16_t*)(p.ws + WS_H) + (size_t)id * 16384 : (bf16_t*)(p.ws + WS_SST) + (size_t)(id - HG_NP) * 16384;
}
constexpr int HP = 144;

__device__ __forceinline__ void hg_gates(const Ctx& X, const Params& p, const bf16_t* PROJ, const HgItem& I, LAS float* part, float (&b)[16], float (&kk)[16], float& bend, float (&pref)[4]) {
    const int col = X.tid & 127, tq = X.tid >> 7;
    const float r0 = p.in[14][I.h * 128 + col], r1 = p.in[14][1024 + I.h * 128 + col];
    const float lb = sigmoidf_(r0 - r1);
    float run = 0.f;
#pragma unroll
    for (int j = 0; j < 16; ++j) {
        const int t = 16 * tq + j;
        float g = 0.f, k1 = 0.f;
        if (t < I.nvalid) {
            const float rf = bf2f((unsigned)PROJ[(size_t)(I.row0 + t) * NPROJ + C_RF + I.h * 128 + col]);
            const float f = lb + (1.f - lb) * sigmoidf_(rf);
            g = __logf(f); k1 = 1.f - f;
        }
        run += g; b[j] = run; kk[j] = k1;
    }
    part[tq * 128 + col] = run;
    __syncthreads();
    float off = 0.f, tot = 0.f;
#pragma unroll
    for (int q = 0; q < 4; ++q) { const float v = part[q * 128 + col]; pref[q] = tot; if (q < tq) off += v; tot += v; }
#pragma unroll
    for (int j = 0; j < 16; ++j) b[j] += off;
    bend = tot;
}
__device__ __forceinline__ void hg_store16(LAS unsigned char* base, int row, int tq, const float (&v)[16]) {
    u32x4 a, c; a.x = pk2(v[0], v[1]); a.y = pk2(v[2], v[3]); a.z = pk2(v[4], v[5]); a.w = pk2(v[6], v[7]);
    c.x = pk2(v[8], v[9]); c.y = pk2(v[10], v[11]); c.z = pk2(v[12], v[13]); c.w = pk2(v[14], v[15]);
    *(LAS u32x4*)(base + row * HP + 32 * tq) = a; *(LAS u32x4*)(base + row * HP + 32 * tq + 16) = c;
}
__device__ __forceinline__ void hg_load_vt(const Ctx& X, const bf16_t* PROJ, const HgItem& I, LAS unsigned char* VT) {
    const int col = X.tid & 127, tq = X.tid >> 7;
    float v[16];
#pragma unroll
    for (int j = 0; j < 16; ++j) { const int t = 16 * tq + j; v[j] = (t < I.nvalid) ? bf2f((unsigned)PROJ[(size_t)(I.row0 + t) * NPROJ + C_RI + I.h * 128 + col]) : 0.f; }
    hg_store16(VT, col, tq, v);
}

__device__ __forceinline__ void hg1_item(const Ctx& X, const Params& p, const bf16_t* PROJ, int id) {
    const HgItem I = hg_item(id);
    LAS unsigned char* KT = X.lds; LAS unsigned char* VT = X.lds + 128 * HP; LAS float* part = (LAS float*)(X.lds + 2 * 128 * HP);
    __syncthreads();
    float b[16], kk[16], bend, pref[4];
    hg_gates(X, p, PROJ, I, part, b, kk, bend, pref);
    const int col = X.tid & 127, tq = X.tid >> 7;
#pragma unroll
    for (int j = 0; j < 16; ++j) kk[j] = kk[j] * __expf(bend - b[j]);
    hg_store16(KT, col, tq, kk);
    hg_load_vt(X, PROJ, I, VT);
    if (tq == 0) ((float*)(p.ws + WS_HD))[(size_t)id * 128 + col] = __expf(bend);
    LDS_WAIT();
    __syncthreads();
    bf16_t* dst = (id < HG_NP) ? hg_state_ptr(p, id) : (bf16_t*)(p.ws + WS_SDL) + (size_t)(id - HG_NP) * 16384;
    const int lane = X.lane, l32 = lane & 31, hi = lane >> 5;
    const int ti = X.wave >> 1;
#pragma unroll
    for (int tt = 0; tt < 2; ++tt) {
        const int tj = 2 * (X.wave & 1) + tt;
        f32x16 acc = {0, 0, 0, 0, 0, 0, 0, 0, 0, 0, 0, 0, 0, 0, 0, 0};
#pragma unroll
        for (int s4 = 0; s4 < 4; ++s4) {
            const bf16x8 a = *(const LAS bf16x8*)(KT + (32 * ti + l32) * HP + 32 * s4 + 16 * hi);
            const bf16x8 bb = *(const LAS bf16x8*)(VT + (32 * tj + l32) * HP + 32 * s4 + 16 * hi);
            acc = __builtin_amdgcn_mfma_f32_32x32x16_bf16(a, bb, acc, 0, 0, 0);
        }
#pragma unroll
        for (int g = 0; g < 4; ++g) {
            u32x2 w; w.x = pk2(acc[4 * g], acc[4 * g + 1]); w.y = pk2(acc[4 * g + 2], acc[4 * g + 3]);
            *(u32x2*)(dst + (size_t)(32 * tj + l32) * 128 + 32 * ti + 8 * g + 4 * hi) = w;
        }
    }
}

__device__ __forceinline__ void hg2_prompt(const Ctx& X, const Params& p, int item) {
    const int e = item * 1024 + 2 * X.tid;
    const int sh = e >> 14, v = (e >> 7) & 127, k = e & 127;
    unsigned* st = (unsigned*)((bf16_t*)(p.ws + WS_H) + (size_t)sh * 256 * 16384 + (size_t)v * 128 + k);
    const float* hd = (const float*)(p.ws + WS_HD) + (size_t)sh * 256 * 128 + k;
    float s0 = 0.f, s1 = 0.f;
    for (int c0 = 0; c0 < 256; c0 += 8) {
        unsigned d[8]; float dx[8], dy[8];
#pragma unroll
        for (int u = 0; u < 8; ++u) { d[u] = st[(size_t)(c0 + u) * 8192]; dx[u] = hd[(c0 + u) * 128]; dy[u] = hd[(c0 + u) * 128 + 1]; }
#pragma unroll
        for (int u = 0; u < 8; ++u) {
            st[(size_t)(c0 + u) * 8192] = pk2(s0, s1);
            s0 = dx[u] * s0 + bflo(d[u]); s1 = dy[u] * s1 + bfhi(d[u]);
        }
    }
    float* o = p.out + O_HP + (size_t)sh * 16384;
    o[k * 128 + v] = s0; o[(k + 1) * 128 + v] = s1;
}
__device__ __forceinline__ void hg2_sample(const Ctx& X, const Params& p, int item) {
    const int e = item * 1024 + 2 * X.tid;
    const int sh = e >> 14, v = (e >> 7) & 127, k = e & 127;
    const float* s0p = p.in[5] + (size_t)sh * 16384;
    const float a0 = s0p[k * 128 + v], a1 = s0p[(k + 1) * 128 + v];
    const size_t off = (size_t)sh * 16384 + (size_t)v * 128 + k;
    *(unsigned*)((bf16_t*)(p.ws + WS_SST) + off) = pk2(a0, a1);
    const unsigned d = *(const unsigned*)((const bf16_t*)(p.ws + WS_SDL) + off);
    const float* hd = (const float*)(p.ws + WS_HD) + (size_t)(HG_NP + sh) * 128 + k;
    float* o = p.out + O_HS + (size_t)sh * 16384;
    o[k * 128 + v] = hd[0] * a0 + bflo(d); o[(k + 1) * 128 + v] = hd[1] * a1 + bfhi(d);
}

constexpr int H3_AQI = 0, H3_AQD = 64 * 272, H3_BK = 2 * 64 * 272, H3_VT = H3_BK + 160 * 272, H3_PL = H3_VT + 128 * HP, H3_MISC = H3_PL + 64 * HP;
__device__ __forceinline__ void hg3_item(const Ctx& X, const Params& p, bf16_t* PROJ, int id) {
    const HgItem I = hg_item(id);
    LAS unsigned char* L = X.lds;
    LAS float* part = (LAS float*)(L + H3_MISC); LAS float* mu = part + 512; LAS float* ssq = mu + 512;
    const int tid = X.tid, col = tid & 127, tq = tid >> 7, lane = X.lane;
    __syncthreads();
    float b[16], kk[16], bend, pref[4];
    hg_gates(X, p, PROJ, I, part, b, kk, bend, pref);
    mu[tq * 128 + col] = b[7];
    for (int i = tid; i < 64 * HP / 16; i += 512) *(LAS u32x4*)(L + H3_PL + 16 * i) = (u32x4){0u, 0u, 0u, 0u};
    LDS_WAIT();
    __syncthreads();
    {
        float mus[4];
#pragma unroll
        for (int q = 0; q < 4; ++q) mus[q] = mu[q * 128 + col];
#pragma unroll
        for (int j = 0; j < 16; ++j) {
            const int t = 16 * tq + j;
            float qq = 0.f;
            if (t < I.nvalid) qq = siluf_(bf2f((unsigned)PROJ[(size_t)(I.row0 + t) * NPROJ + C_RQ + I.h * 128 + col]));
            *(LAS bf16_t*)(L + H3_AQI + t * 272 + 2 * col) = (bf16_t)f2bf(qq * __expf(b[j]));
            *(LAS bf16_t*)(L + H3_AQD + t * 272 + 2 * col) = (bf16_t)f2bf(qq * __expf(b[j] - mus[tq]));
#pragma unroll
            for (int i = 0; i < 4; ++i) {
                if (i >= tq) {
                    const int rbase = 8 * i * (i + 1);
                    *(LAS bf16_t*)(L + H3_BK + (rbase + t) * 272 + 2 * col) = (bf16_t)f2bf(kk[j] * __expf(mus[i] - b[j]));
                }
            }
        }
        hg_load_vt(X, PROJ, I, L + H3_VT);
    }
    LDS_WAIT();
    __syncthreads();
    const int l32 = lane & 31, hi = lane >> 5, l16 = lane & 15, lq = lane >> 4;
    const int ti = X.wave >> 2, tj = X.wave & 3;
    f32x16 acc = {0, 0, 0, 0, 0, 0, 0, 0, 0, 0, 0, 0, 0, 0, 0, 0};
    {
        const bf16_t* sp = hg_state_ptr(p, id) + (size_t)(32 * tj + l32) * 128 + 8 * hi;
#pragma unroll
        for (int ks = 0; ks < 8; ++ks) {
            const bf16x8 a = *(const LAS bf16x8*)(L + H3_AQI + (32 * ti + l32) * 272 + 32 * ks + 16 * hi);
            const bf16x8 bb = *(const bf16x8*)(sp + 16 * ks);
            acc = __builtin_amdgcn_mfma_f32_32x32x16_bf16(a, bb, acc, 0, 0, 0);
        }
    }
    for (int tile = X.wave; tile < 10; tile += 8) {
        int i = 0, js = tile; while (js > i) { js -= i + 1; ++i; }
        const int rbase = 8 * i * (i + 1);
        f32x4 pc = {0.f, 0.f, 0.f, 0.f};
#pragma unroll
        for (int ks = 0; ks < 4; ++ks) {
            const bf16x8 a = *(const LAS bf16x8*)(L + H3_AQD + (16 * i + l16) * 272 + 64 * ks + 16 * lq);
            const bf16x8 bb = *(const LAS bf16x8*)(L + H3_BK + (rbase + 16 * js + l16) * 272 + 64 * ks + 16 * lq);
            pc = __builtin_amdgcn_mfma_f32_16x16x32_bf16(a, bb, pc, 0, 0, 0);
        }
#pragma unroll
        for (int r = 0; r < 4; ++r) {
            const int tl = 4 * lq + r; float v = pc[r];
            if (js == i && l16 > tl) v = 0.f;
            *(LAS bf16_t*)(L + H3_PL + (16 * i + tl) * HP + 2 * (16 * js + l16)) = (bf16_t)f2bf(v);
        }
    }
    LDS_WAIT();
    __syncthreads();
#pragma unroll
    for (int ss = 0; ss < 4; ++ss) {
        const bf16x8 a = *(const LAS bf16x8*)(L + H3_PL + (32 * ti + l32) * HP + 32 * ss + 16 * hi);
        const bf16x8 bb = *(const LAS bf16x8*)(L + H3_VT + (32 * tj + l32) * HP + 32 * ss + 16 * hi);
        acc = __builtin_amdgcn_mfma_f32_32x32x16_bf16(a, bb, acc, 0, 0, 0);
    }
#pragma unroll
    for (int r = 0; r < 16; ++r) {
        float s = acc[r] * acc[r];
        s += __shfl_xor(s, 1); s += __shfl_xor(s, 2); s += __shfl_xor(s, 4); s += __shfl_xor(s, 8); s += __shfl_xor(s, 16);
        if (l32 == 0) ssq[(32 * ti + 8 * (r >> 2) + 4 * hi + (r & 3)) * 4 + tj] = s;
    }
    LDS_WAIT();
    __syncthreads();
    const int v = 32 * tj + l32;
    const float gr = p.in[15][v];
#pragma unroll
    for (int r = 0; r < 16; ++r) {
        const int t = 32 * ti + 8 * (r >> 2) + 4 * hi + (r & 3);
        if (t < I.nvalid) {
            const f32x4 q4 = *(const LAS f32x4*)(ssq + t * 4);
            const float rs = 1.f / sqrtf(((q4.x + q4.y) + (q4.z + q4.w)) * (1.f / 128) + EPS);
            bf16_t* pr = PROJ + (size_t)(I.row0 + t) * NPROJ;
            const float rg = bf2f((unsigned)pr[C_RG + I.h * 128 + v]);
            pr[C_RQ + I.h * 128 + v] = (bf16_t)f2bf(acc[r] * rs * gr * siluf_(rg));
        }
    }
}

__global__ void __launch_bounds__(512, 2) mega(Params p) {
    extern __shared__ __attribute__((aligned(16))) unsigned char smem[];
    Ctx X; X.lds = (LAS unsigned char*)smem; X.tid = threadIdx.x; X.lane = X.tid & 63; X.wave = __builtin_amdgcn_readfirstlane(X.tid >> 6); X.G = gridDim.x; X.bid = blockIdx.x;
    cg::grid_group grid = cg::this_grid();
    unsigned char* ws = p.ws;
    bf16_t* WA = (bf16_t*)(ws + WS_A); bf16_t* WB = (bf16_t*)(ws + WS_B); bf16_t* WATT = (bf16_t*)(ws + WS_WATT); bf16_t* WREC = (bf16_t*)(ws + WS_WREC); bf16_t* WOUT = (bf16_t*)(ws + WS_WOUT);
    bf16_t* H = (bf16_t*)(ws + WS_H); bf16_t* BIG = (bf16_t*)(ws + WS_BIG); bf16_t* IDX = (bf16_t*)(ws + WS_IDX);
    float* Y = p.out + O_Y;
    const int lo = p.ph_lo, hi = p.ph_hi;
#define IN(k) (lo <= (k) && (k) < hi)
#define SEAM(k) do { if (IN(k) && IN((k) + 1)) grid.sync(); } while (0)
    if (IN(0)) {
        convert_weight<1>(X, p.in[7], DM, NFF, WA);
        convert_weight<0>(X, p.in[8], DFF, DM, WB);
        convert_weight<0>(X, p.in[16], 1024, DM, WATT);
        convert_weight<0>(X, p.in[17], 1024, DM, WREC);
        convert_weight<0>(X, p.in[18], DM, DM, WOUT);
        rmsnorm_rows(X, p.in[0], p.in[1], p.in[6], H);
    }
    SEAM(0);
    if (IN(1)) {
        pg8::Gemm g{H, WA, MT, NFF, DM, DM}; pg8::StaticOrder S; S.init(MT, NFF, X.G, X.bid);
        pg8::Epi<pg8::EPI_SWIGLU> E{BIG, nullptr, nullptr, nullptr, 0.f};
        pg8::gemm_phase<pg8::Epi<pg8::EPI_SWIGLU>, pg8::StaticOrder, true, true>(X.lds, g, S, E);
    }
    SEAM(1);
    if (IN(2)) {
        convert_weight<2>(X, p.in[10], DM, 10832, WA);
        for (size_t i = ((size_t)X.bid * 512 + X.tid) * 8; i < (size_t)(NPROJ - 10832) * DM; i += (size_t)X.G * 512 * 8) *(u32x4*)(WA + (size_t)10832 * DM + i) = (u32x4){0u, 0u, 0u, 0u};
        __syncthreads();
        pg8::Gemm g{BIG, WB, MT, DM, DFF, DFF}; pg8::StaticOrder S; S.init(MT, DM, X.G, X.bid);
        pg8::Epi<pg8::EPI_RESID> E{nullptr, Y, p.in[0], p.in[1], 0.5f};
        pg8::gemm_phase<pg8::Epi<pg8::EPI_RESID>, pg8::StaticOrder, true, true>(X.lds, g, S, E);
    }
    SEAM(2);
    if (IN(3)) {
        rmsnorm_rows(X, Y, Y + (size_t)MP * DM, p.in[9], H);
        convert_weight<0>(X, p.in[21], DFF, DM, WB);
        convert_flat(X, p.in[2], (bf16_t*)(ws + WS_CK), (size_t)8 * PAST * 256);
        convert_flat(X, p.in[3], (bf16_t*)(ws + WS_CV), (size_t)8 * PAST * 256);
        convert_flat(X, p.in[4], (bf16_t*)(ws + WS_CKI), (size_t)8 * PAST * 64);
    }
    SEAM(3);
    if (IN(4)) {
        pg8::Gemm g{H, WA, MT, NPROJ, DM, DM}; pg8::StaticOrder S; S.init(MT, NPROJ, X.G, X.bid);
        pg8::Epi<pg8::EPI_PROJ> E{BIG, nullptr, nullptr, nullptr, 0.f};
        pg8::gemm_phase<pg8::Epi<pg8::EPI_PROJ>, pg8::StaticOrder, true, true>(X.lds, g, S, E);
    }
    SEAM(4);
    if (IN(5)) {
        postproj_rows(X, p, BIG);
        convert_weight<1>(X, p.in[20], DM, NFF, WA);
    }
    SEAM(5);
    if (IN(6)) {
        for (int it = X.bid; it < HG_NP + HG_NS; it += X.G) hg1_item(X, p, BIG, it);
        for (int it = X.bid; it < MT / 8; it += X.G) indexer_item(X, p, BIG, IDX, it);
    }
    SEAM(6);
    if (IN(7)) {
        for (int it = X.bid; it < 256; it += X.G) hg2_prompt(X, p, it);
        for (int it = X.bid; it < 1024; it += X.G) hg2_sample(X, p, it);
        attn_setup(X, p);
        for (int m = X.bid * 8 + X.wave; m < MT; m += X.G * 8) attn_query(X, p, BIG, IDX, m);
    }
    SEAM(7);
    if (IN(8)) {
        for (int it = X.bid; it < HG_NP + HG_NS; it += X.G) hg3_item(X, p, BIG, it);
        __syncthreads();
    }
    SEAM(8);
    if (IN(9)) {
        pg8::Gemm g{BIG + C_Q, WATT, MT, DM, 1024, NPROJ}; pg8::StaticOrder S; S.init(MT, DM, X.G, X.bid);
        pg8::Epi<pg8::EPI_MERGE1> E{BIG, nullptr, nullptr, nullptr, 0.f};
        pg8::gemm_phase<pg8::Epi<pg8::EPI_MERGE1>, pg8::StaticOrder, true, true>(X.lds, g, S, E);
    }
    SEAM(9);
    if (IN(10)) {
        pg8::Gemm g{BIG + C_RQ, WREC, MT, DM, 1024, NPROJ}; pg8::StaticOrder S; S.init(MT, DM, X.G, X.bid);
        pg8::Epi<pg8::EPI_MERGE2> E{BIG, nullptr, nullptr, nullptr, 0.f};
        pg8::gemm_phase<pg8::Epi<pg8::EPI_MERGE2>, pg8::StaticOrder, true, true>(X.lds, g, S, E);
    }
    SEAM(10);
    if (IN(11)) {
        pg8::Gemm g{BIG + C_GA, WOUT, MT, DM, DM, NPROJ}; pg8::StaticOrder S; S.init(MT, DM, X.G, X.bid);
        pg8::Epi<pg8::EPI_RESID> E{nullptr, Y, Y, Y + (size_t)MP * DM, 1.f};
        pg8::gemm_phase<pg8::Epi<pg8::EPI_RESID>, pg8::StaticOrder, true, true>(X.lds, g, S, E);
    }
    SEAM(11);
    if (IN(12)) rmsnorm_rows(X, Y, Y + (size_t)MP * DM, p.in[19], H);
    SEAM(12);
    if (IN(13)) {
        pg8::Gemm g{H, WA, MT, NFF, DM, DM}; pg8::StaticOrder S; S.init(MT, NFF, X.G, X.bid);
        pg8::Epi<pg8::EPI_SWIGLU> E{BIG, nullptr, nullptr, nullptr, 0.f};
        pg8::gemm_phase<pg8::Epi<pg8::EPI_SWIGLU>, pg8::StaticOrder, true, true>(X.lds, g, S, E);
    }
    SEAM(13);
    if (IN(14)) {
        pg8::Gemm g{BIG, WB, MT, DM, DFF, DFF}; pg8::StaticOrder S; S.init(MT, DM, X.G, X.bid);
        pg8::Epi<pg8::EPI_RESID> E{nullptr, Y, Y, Y + (size_t)MP * DM, 0.5f};
        pg8::gemm_phase<pg8::Epi<pg8::EPI_RESID>, pg8::StaticOrder, true, true>(X.lds, g, S, E);
    }
}

#ifndef N_LAUNCH_MODE
#define N_LAUNCH_MODE 1
#endif
extern "C" void kernel_launch(void* const* d_in, const int* in_sizes, int n_in, void* d_out, int out_size, void* d_ws, size_t ws_size, hipStream_t stream) {
    static int grid_blocks = 0;
    if (!grid_blocks) {
        hipFuncSetAttribute((const void*)mega, hipFuncAttributeMaxDynamicSharedMemorySize, LDS_BYTES);
        int dev = 0, cus = 0, per_cu = 0;
        hipGetDevice(&dev);
        hipDeviceGetAttribute(&cus, hipDeviceAttributeMultiprocessorCount, dev);
        hipOccupancyMaxActiveBlocksPerMultiprocessor(&per_cu, mega, 512, LDS_BYTES);
        if (per_cu < 1) per_cu = 1;
        grid_blocks = cus * 1;
        if (ws_size < WS_END) fprintf(stderr, "workspace too small: %zu < %zu\n", ws_size, (size_t)WS_END);
    }
    Params p{};
    for (int i = 0; i < 22; ++i) p.in[i] = (const float*)d_in[i];
    p.out = (float*)d_out; p.ws = (unsigned char*)d_ws;
#if N_LAUNCH_MODE == 1
    p.ph_lo = 0; p.ph_hi = NPH;
    void* args[] = {&p};
    hipError_t e = hipLaunchCooperativeKernel((const void*)mega, dim3(grid_blocks), dim3(512), args, LDS_BYTES, stream);
    if (e != hipSuccess) fprintf(stderr, "cooperative launch failed: %s (grid %d)\n", hipGetErrorString(e), grid_blocks);
#else
    for (int k = 0; k < NPH; ++k) {
        p.ph_lo = k; p.ph_hi = k + 1;
        hipLaunchKernelGGL(mega, dim3(grid_blocks), dim3(512), LDS_BYTES, stream, p);
    }
#endif
}
```

```cpp
#include <hip/hip_runtime.h>
#include <hip/hip_cooperative_groups.h>
#include <cstdio>
#include <cstdint>
namespace cg = cooperative_groups;

#define LAS __attribute__((address_space(3)))
typedef unsigned short bf16_t;
typedef short bf16x8 __attribute__((ext_vector_type(8)));
typedef float f32x4 __attribute__((ext_vector_type(4)));
typedef float f32x16 __attribute__((ext_vector_type(16)));
typedef unsigned u32x4 __attribute__((ext_vector_type(4)));
typedef unsigned u32x2 __attribute__((ext_vector_type(2)));

constexpr int DM = 2048, MP = 32768, MS = 256, MT = MP + MS, DFF = 5632, NFF = 2 * DFF, NPROJ = 11008;
constexpr int SEQ = 16384, DSEQ = 32, PAST = 4096, LS = PAST + DSEQ;
constexpr float EPS = 1e-6f;
constexpr int C_Q = 0, C_K = 1024, C_V = 1280, C_QI = 1536, C_RF = 2560, C_RQ = 3584, C_RI = 4608, C_RG = 5632, C_GA = 6656, C_GB = 8704, C_KI = 10752, C_WI = 10816;
constexpr size_t O_Y = 0, O_KP = 67633152, O_VP = 76021760, O_KIP = 84410368, O_HP = 86507520, O_KS = 86769664, O_VS = 86835200, O_KIS = 86900736, O_HS = 86917120;
constexpr size_t MiB = 1u << 20;
constexpr size_t WS_A = 1 * MiB, WS_B = 45 * MiB, WS_WATT = 67 * MiB, WS_WREC = 71 * MiB, WS_WOUT = 75 * MiB, WS_H = 83 * MiB, WS_BIG = 212 * MiB,
                 WS_IDX = 906 * MiB, WS_CK = 923 * MiB, WS_CV = 939 * MiB, WS_CKI = 955 * MiB, WS_SST = 959 * MiB, WS_SDL = 961 * MiB, WS_HD = 963 * MiB, WS_END = 966 * MiB;
constexpr int LDS_BYTES = 147456;
constexpr int NPH = 15;

struct Params {
    const float* in[22];
    float* out;
    unsigned char* ws;
    int ph_lo, ph_hi;
};

__device__ __forceinline__ unsigned f2bf(float f) { unsigned u = __builtin_bit_cast(unsigned, f); return (u + 0x7fffu + ((u >> 16) & 1u)) >> 16; }
typedef float f32x2_t __attribute__((ext_vector_type(2)));
typedef __bf16 bf16x2_t __attribute__((ext_vector_type(2)));
__device__ __forceinline__ unsigned pk2(float lo, float hi) { f32x2_t v = {lo, hi}; bf16x2_t b = __builtin_convertvector(v, bf16x2_t); return __builtin_bit_cast(unsigned, b); }
__device__ __forceinline__ float bf2f(unsigned h) { return __builtin_bit_cast(float, h << 16); }
__device__ __forceinline__ float bflo(unsigned w) { return __builtin_bit_cast(float, w << 16); }
__device__ __forceinline__ float bfhi(unsigned w) { return __builtin_bit_cast(float, w & 0xffff0000u); }
__device__ __forceinline__ float sigmoidf_(float x) { return __builtin_amdgcn_rcpf(1.f + __expf(-x)); }
__device__ __forceinline__ float siluf_(float x) { return x * sigmoidf_(x); }
__device__ __forceinline__ float wave_sum(float v) {
#pragma unroll
    for (int o = 1; o < 64; o <<= 1) v += __shfl_xor(v, o);
    return v;
}
#define LDS_WAIT() asm volatile("s_waitcnt lgkmcnt(0)" ::: "memory")

namespace pg8 {
#define PG8_LAS __attribute__((address_space(3)))
constexpr int BM = 256, BK = 64, HALF = 128, HTB = HALF * BK * 2, STAGE_BYTES = 8 * HTB, NXCD = 8, WGM = 8;
__host__ __device__ __forceinline__ int lds_byte(int r, int c) { const int st = (r >> 4) * 2 + (c >> 5), rr = r & 15, cc = c & 31, ob = rr * 64 + cc * 2; return st * 1024 + (ob ^ (((ob >> 9) & 1) << 5)); }
__host__ __device__ __forceinline__ void stage_rc(int b, int& R, int& C) { const int st = b / 1024, sb = b % 1024, swz = sb ^ (((sb >> 9) & 1) << 5); R = (st >> 1) * 16 + swz / 64; C = (st & 1) * 32 + (swz % 64) / 2; }
__host__ __device__ __forceinline__ int perm32(int rho) { const int n = rho >> 4, i = rho & 15; return 8 * (i >> 2) + 4 * n + (i & 3); }
struct Unit { int pm, pn; };
struct Gemm { const bf16_t* A; const bf16_t* Bt; int M, N, K, lda; };
struct StaticOrder {
    int nM, nN, nwg, G, c;
    __host__ __device__ void init(int M, int N, int G_, int c_) { nM = M / BM; nN = N / BM; nwg = nM * nN; G = G_; c = c_; }
    __host__ __device__ bool next(int i, Unit& u) const {
        const long L = (long)i * G + c; if (L >= nwg) return false;
        int wgid = (int)L; { const int q = nwg / NXCD, r = nwg % NXCD, xcd = wgid % NXCD, off = wgid / NXCD; wgid = (xcd < r ? xcd * (q + 1) : r * (q + 1) + (xcd - r) * q) + off; }
        const int nig = WGM * nN, gid = wgid / nig, fm = gid * WGM, gsz = (nM - fm) < WGM ? (nM - fm) : WGM;
        u.pm = fm + ((wgid % nig) % gsz); u.pn = (wgid % nig) / gsz; return true;
    }
    __device__ __forceinline__ void a_ready(const Unit&) const {}
    __device__ __forceinline__ void done(const Unit&) const {}
};

enum { EPI_SWIGLU = 0, EPI_RESID = 1, EPI_PROJ = 2, EPI_MERGE1 = 3, EPI_MERGE2 = 4 };
template <int MODE> struct Epi {
    static constexpr bool PERM = true, AFTER_DRAIN = false;
    bf16_t* O; float* Y; const float* R0; const float* R1; float alpha;
    __device__ __forceinline__ void operator()(const f32x4 (&acc)[2][2][4][2], const Unit& u, int wr, int wc, int fr, int fq) const {
        const int row0 = u.pm * BM + wr * 64 + fr;
        if constexpr (MODE == EPI_SWIGLU) {
            const int col0 = u.pn * 128 + wc * 32 + 8 * fq;
#pragma unroll
            for (int ai = 0; ai < 2; ++ai)
#pragma unroll
                for (int m = 0; m < 4; ++m) {
                    const int row = row0 + ai * HALF + m * 16;
                    float h[8];
#pragma unroll
                    for (int n = 0; n < 2; ++n)
#pragma unroll
                        for (int j = 0; j < 4; ++j) { const float g = acc[ai][0][m][n][j], up = acc[ai][1][m][n][j]; h[4 * n + j] = siluf_(g) * up; }
                    u32x4 w; w.x = pk2(h[0], h[1]); w.y = pk2(h[2], h[3]); w.z = pk2(h[4], h[5]); w.w = pk2(h[6], h[7]);
                    *(u32x4*)(O + (size_t)row * DFF + col0) = w;
                }
        } else if constexpr (MODE == EPI_RESID) {
#pragma unroll
            for (int ai = 0; ai < 2; ++ai)
#pragma unroll
                for (int m = 0; m < 4; ++m) {
                    const int row = row0 + ai * HALF + m * 16;
                    const float* rp = (row < MP) ? R0 + (size_t)row * DM : R1 + (size_t)(row - MP) * DM;
                    float* yp = Y + (size_t)row * DM;
#pragma unroll
                    for (int bj = 0; bj < 2; ++bj) {
                        const int col = u.pn * BM + bj * HALF + wc * 32 + 8 * fq;
                        const f32x4 r0 = *(const f32x4*)(rp + col), r1 = *(const f32x4*)(rp + col + 4);
                        *(f32x4*)(yp + col) = r0 + acc[ai][bj][m][0] * alpha;
                        *(f32x4*)(yp + col + 4) = r1 + acc[ai][bj][m][1] * alpha;
                    }
                }
        } else {
            const bool sig = (MODE == EPI_PROJ) && (u.pn >= C_GA / 256) && (u.pn < C_KI / 256);
#pragma unroll
            for (int ai = 0; ai < 2; ++ai)
#pragma unroll
                for (int m = 0; m < 4; ++m) {
                    const int row = row0 + ai * HALF + m * 16;
#pragma unroll
                    for (int bj = 0; bj < 2; ++bj) {
                        const int col = u.pn * BM + bj * HALF + wc * 32 + 8 * fq;
                        float v[8];
#pragma unroll
                        for (int n = 0; n < 2; ++n)
#pragma unroll
                            for (int j = 0; j < 4; ++j) v[4 * n + j] = acc[ai][bj][m][n][j];
                        bf16_t* op;
                        if constexpr (MODE == EPI_PROJ) {
                            op = O + (size_t)row * NPROJ + col;
                            if (sig) {
#pragma unroll
                                for (int e = 0; e < 8; ++e) v[e] = sigmoidf_(v[e]);
                            }
                        } else {
                            op = O + (size_t)row * NPROJ + C_GA + col;
                            const u32x4 g = *(const u32x4*)op;
                            const float gv[8] = {bflo(g.x), bfhi(g.x), bflo(g.y), bfhi(g.y), bflo(g.z), bfhi(g.z), bflo(g.w), bfhi(g.w)};
                            if constexpr (MODE == EPI_MERGE1) {
#pragma unroll
                                for (int e = 0; e < 8; ++e) v[e] = gv[e] * v[e];
                            } else {
                                const u32x4 g2 = *(const u32x4*)(op + (C_GB - C_GA));
                                const float hv[8] = {bflo(g2.x), bfhi(g2.x), bflo(g2.y), bfhi(g2.y), bflo(g2.z), bfhi(g2.z), bflo(g2.w), bfhi(g2.w)};
#pragma unroll
                                for (int e = 0; e < 8; ++e) v[e] = gv[e] + hv[e] * v[e];
                            }
                        }
                        u32x4 w; w.x = pk2(v[0], v[1]); w.y = pk2(v[2], v[3]); w.z = pk2(v[4], v[5]); w.w = pk2(v[6], v[7]);
                        *(u32x4*)op = w;
                    }
                }
        }
    }
};

template <class Epi, class Sched, bool ALIGN_EPI = false, bool SP2 = false>
__device__ __forceinline__ void gemm_phase(PG8_LAS unsigned char* lds, const Gemm g, const Sched& S, const Epi& E) {
    const int tid = threadIdx.x, wid = __builtin_amdgcn_readfirstlane(tid >> 6), lane = tid & 63, wr = wid >> 2, wc = wid & 3, fr = lane & 15, fq = lane >> 4;
    const int K = g.K, nt = K / BK;
    unsigned voffA[2], voffB[2];
#pragma unroll
    for (int i = 0; i < 2; ++i) { int R, C; stage_rc(tid * 16 + i * 8192, R, C); const int Rb = Epi::PERM ? ((R & ~31) + perm32(R & 31)) : R;
        voffA[i] = (unsigned)(R * g.lda + C) * 2u; voffB[i] = (unsigned)(Rb * K + C) * 2u; }
    const size_t kstep = (size_t)(BK * 2);
    const size_t hstepB = (size_t)HALF * K * 2, hstepA = (size_t)HALF * g.lda * 2;
    const size_t tstepA = 2 * hstepA, tstepB = 2 * hstepB;
    const unsigned ldsw = (unsigned)wid * 1024u;
    const int aoff = lds_byte(wr * 64 + fr, fq * 8), boff = lds_byte(wc * 32 + fr, fq * 8);
#define PG8_SA(b, h) (((b) * 2 + (h)) * HTB)
#define PG8_SB(b, h) ((4 + (b) * 2 + (h)) * HTB)
#define PG8_STAGE(bufoff, gbase, voff) do { _Pragma("unroll") for (int _i = 0; _i < 2; ++_i) \
        __builtin_amdgcn_global_load_lds((const unsigned*)((const char*)(gbase) + (voff)[_i]), (PG8_LAS unsigned*)(lds + (bufoff) + ldsw + _i * 8192), 16, 0, 0); } while (0)
#define PG8_LDA(dst, b, h) do { _Pragma("unroll") for (int m = 0; m < 4; ++m) _Pragma("unroll") for (int k = 0; k < 2; ++k) dst[m][k] = *(const PG8_LAS bf16x8*)(lds + PG8_SA(b, h) + aoff + m * 2048 + k * 1024); } while (0)
#define PG8_LDB(dst, b, h) do { _Pragma("unroll") for (int n = 0; n < 2; ++n) _Pragma("unroll") for (int k = 0; k < 2; ++k) dst[n][k] = *(const PG8_LAS bf16x8*)(lds + PG8_SB(b, h) + boff + n * 2048 + k * 1024); } while (0)
#define PG8_MMA(ai, bj, At, Bt) do { __builtin_amdgcn_s_setprio(1); _Pragma("unroll") for (int m = 0; m < 4; ++m) _Pragma("unroll") for (int n = 0; n < 2; ++n) _Pragma("unroll") for (int k = 0; k < 2; ++k) \
        acc[ai][bj][m][n] = __builtin_amdgcn_mfma_f32_16x16x32_bf16(Bt[n][k], At[m][k], acc[ai][bj][m][n], 0, 0, 0); __builtin_amdgcn_s_setprio(0); } while (0)
#define PG8_WAIT_V(n) asm volatile("s_waitcnt vmcnt(" #n ")" ::: "memory")
#define PG8_WAIT_L(n) asm volatile("s_waitcnt lgkmcnt(" #n ")" ::: "memory")
#define PG8_BAR __builtin_amdgcn_s_barrier()
#define PG8_SCHED __builtin_amdgcn_sched_barrier(0)
    Unit cur, nxt; int ui = 0;
    if (!S.next(0, cur)) return;
    f32x4 acc[2][2][4][2];
#pragma unroll
    for (int a = 0; a < 2; ++a)
#pragma unroll
        for (int b = 0; b < 2; ++b)
#pragma unroll
            for (int m = 0; m < 4; ++m)
#pragma unroll
                for (int n = 0; n < 2; ++n) acc[a][b][m][n] = (f32x4){0.f, 0.f, 0.f, 0.f};
    bf16x8 At[4][2], B0[2][2], B1[2][2];
    const char* cA = (const char*)g.A + (size_t)cur.pm * tstepA; const char* cB = (const char*)g.Bt + (size_t)cur.pn * tstepB;
    S.a_ready(cur);
    if constexpr (SP2) {
        PG8_STAGE(PG8_SB(0, 0), cB, voffB); PG8_STAGE(PG8_SB(0, 1), cB + hstepB, voffB); PG8_STAGE(PG8_SA(0, 0), cA, voffA); PG8_STAGE(PG8_SA(0, 1), cA + hstepA, voffA);
        if (wr == 1) PG8_BAR;
        PG8_WAIT_V(2); PG8_BAR;
        PG8_STAGE(PG8_SB(1, 0), cB + kstep, voffB); PG8_STAGE(PG8_SA(1, 0), cA + kstep, voffA); PG8_STAGE(PG8_SB(1, 1), cB + hstepB + kstep, voffB);
        PG8_WAIT_V(6); PG8_BAR;
    } else {
        PG8_STAGE(PG8_SB(0, 0), cB, voffB); PG8_STAGE(PG8_SA(0, 0), cA, voffA); PG8_STAGE(PG8_SB(0, 1), cB + hstepB, voffB); PG8_STAGE(PG8_SA(0, 1), cA + hstepA, voffA);
        if (wr == 1) PG8_BAR;
        PG8_WAIT_V(4); PG8_BAR;
        PG8_STAGE(PG8_SB(1, 0), cB + kstep, voffB); PG8_STAGE(PG8_SA(1, 0), cA + kstep, voffA); PG8_STAGE(PG8_SB(1, 1), cB + hstepB + kstep, voffB);
        PG8_WAIT_V(6); PG8_BAR;
    }
    for (;;) {
        const bool has_next = S.next(ui + 1, nxt);
        const char* nA = has_next ? (const char*)g.A + (size_t)nxt.pm * tstepA : cA; const char* nB = has_next ? (const char*)g.Bt + (size_t)nxt.pn * tstepB : cB;
        for (int t = 0; t < nt; t += 2) {
            const bool last = (t == nt - 2);
            const char* a1 = cA + (size_t)(t + 1) * kstep;
            const char* a2 = last ? nA : cA + (size_t)(t + 2) * kstep; const char* b2 = last ? nB : cB + (size_t)(t + 2) * kstep;
            const char* a3 = a2 + kstep; const char* b3 = b2 + kstep;
            if (last && has_next) S.a_ready(nxt);
            if constexpr (SP2) {
            PG8_LDB(B0, 0, 0); PG8_LDB(B1, 0, 1); PG8_SCHED; PG8_LDA(At, 0, 0); PG8_STAGE(PG8_SA(1, 1), a1 + hstepA, voffA);
            PG8_WAIT_V(8); PG8_WAIT_L(0); PG8_BAR; PG8_MMA(0, 0, At, B0); PG8_MMA(0, 1, At, B1); PG8_BAR; PG8_SCHED;
            PG8_LDA(At, 0, 1); PG8_STAGE(PG8_SB(0, 0), b2, voffB); PG8_STAGE(PG8_SB(0, 1), b2 + hstepB, voffB); PG8_STAGE(PG8_SA(0, 0), a2, voffA);
            PG8_WAIT_V(8); PG8_WAIT_L(0); PG8_BAR; PG8_MMA(1, 0, At, B0); PG8_MMA(1, 1, At, B1); PG8_BAR; PG8_SCHED;
            PG8_LDB(B0, 1, 0); PG8_LDB(B1, 1, 1); PG8_SCHED; PG8_LDA(At, 1, 0); PG8_STAGE(PG8_SA(0, 1), a2 + hstepA, voffA);
            PG8_WAIT_V(8); PG8_WAIT_L(0); PG8_BAR; PG8_MMA(0, 0, At, B0); PG8_MMA(0, 1, At, B1); PG8_BAR; PG8_SCHED;
            PG8_LDA(At, 1, 1); PG8_STAGE(PG8_SB(1, 0), b3, voffB); PG8_STAGE(PG8_SB(1, 1), b3 + hstepB, voffB); PG8_STAGE(PG8_SA(1, 0), a3, voffA);
            PG8_WAIT_V(8); PG8_WAIT_L(0); PG8_BAR; PG8_MMA(1, 0, At, B0); PG8_MMA(1, 1, At, B1); PG8_BAR; PG8_SCHED;
            } else {
            PG8_LDB(B0, 0, 0); PG8_SCHED; PG8_LDA(At, 0, 0); PG8_STAGE(PG8_SA(1, 1), a1 + hstepA, voffA);
            PG8_WAIT_L(8); PG8_BAR; PG8_WAIT_L(0); PG8_MMA(0, 0, At, B0); PG8_BAR; PG8_SCHED;
            PG8_LDB(B1, 0, 1); PG8_STAGE(PG8_SB(0, 0), b2, voffB);
            PG8_BAR; PG8_WAIT_L(0); PG8_MMA(0, 1, At, B1); PG8_BAR;
            PG8_LDA(At, 0, 1); PG8_STAGE(PG8_SA(0, 0), a2, voffA);
            PG8_BAR; PG8_WAIT_L(0); PG8_MMA(1, 0, At, B0); PG8_BAR; PG8_SCHED;
            PG8_STAGE(PG8_SB(0, 1), b2 + hstepB, voffB);
            PG8_WAIT_V(6); PG8_BAR; PG8_MMA(1, 1, At, B1); PG8_BAR;
            PG8_LDB(B0, 1, 0); PG8_SCHED; PG8_LDA(At, 1, 0); PG8_STAGE(PG8_SA(0, 1), a2 + hstepA, voffA);
            PG8_WAIT_L(8); PG8_BAR; PG8_WAIT_L(0); PG8_MMA(0, 0, At, B0); PG8_BAR; PG8_SCHED;
            PG8_LDB(B1, 1, 1); PG8_STAGE(PG8_SB(1, 0), b3, voffB);
            PG8_BAR; PG8_WAIT_L(0); PG8_MMA(0, 1, At, B1); PG8_BAR;
            PG8_LDA(At, 1, 1); PG8_STAGE(PG8_SA(1, 0), a3, voffA);
            PG8_BAR; PG8_WAIT_L(0); PG8_MMA(1, 0, At, B0); PG8_BAR; PG8_SCHED;
            PG8_STAGE(PG8_SB(1, 1), b3 + hstepB, voffB);
            PG8_WAIT_V(6); PG8_BAR; PG8_MMA(1, 1, At, B1); PG8_BAR;
            }
        }
        if constexpr (ALIGN_EPI) { if (wr == 0) PG8_BAR; }
        if constexpr (!Epi::AFTER_DRAIN) { E(acc, cur, wr, wc, fr, fq); S.done(cur); }
        if (!has_next) break;
#pragma unroll
        for (int a = 0; a < 2; ++a)
#pragma unroll
            for (int b = 0; b < 2; ++b)
#pragma unroll
                for (int m = 0; m < 4; ++m)
#pragma unroll
                    for (int n = 0; n < 2; ++n) acc[a][b][m][n] = (f32x4){0.f, 0.f, 0.f, 0.f};
        cur = nxt; cA = nA; cB = nB; ++ui;
        if constexpr (ALIGN_EPI) { if (wr == 1) PG8_BAR; }
    }
    PG8_WAIT_V(0);
    if constexpr (!ALIGN_EPI) { if (wr == 0) PG8_BAR; }
    PG8_BAR;
    if constexpr (Epi::AFTER_DRAIN) { E.fused(acc, cur, wr, wc, fr, fq, lds, wid, lane); S.done(cur); }
#undef PG8_SA
#undef PG8_SB
#undef PG8_STAGE
#undef PG8_LDA
#undef PG8_LDB
#undef PG8_MMA
#undef PG8_WAIT_V
#undef PG8_WAIT_L
#undef PG8_BAR
#undef PG8_SCHED
}
}

struct Ctx {
    LAS unsigned char* lds;
    int tid, lane, wave, G, bid;
};

template <int MAP> __device__ __forceinline__ int wmap(int c) {
    if constexpr (MAP == 1) { return c < DFF ? (256 * (c >> 7) + (c & 127)) : (256 * ((c - DFF) >> 7) + 128 + ((c - DFF) & 127)); }
    else if constexpr (MAP == 2) { return c < 2560 ? c : (c < 2624 ? C_KI + (c - 2560) : (c < 2640 ? C_WI + (c - 2624) : c - 80)); }
    else return c;
}
template <int MAP> __device__ __forceinline__ void transpose_tile(const Ctx& X, const float* W, int K, int N, bf16_t* WT, int item) {
    LAS float* scr = (LAS float*)X.lds;
    const int nblk = (N + 63) / 64, kb = item / nblk, nb = item % nblk, k0 = 64 * kb, n0 = 64 * nb;
    const int j = X.tid & 63, i0 = X.tid >> 6;
    __syncthreads();
#pragma unroll
    for (int r = 0; r < 8; ++r) { const int i = i0 + 8 * r; scr[i * 65 + j] = (n0 + j < N) ? W[(size_t)(k0 + i) * N + n0 + j] : 0.f; }
    __syncthreads();
    const int c = X.tid & 7, n = X.tid >> 3;
    if (n0 + n < N) {
        const LAS float* s = scr + (8 * c) * 65 + n;
        u32x4 o; o.x = pk2(s[0], s[65]); o.y = pk2(s[2 * 65], s[3 * 65]); o.z = pk2(s[4 * 65], s[5 * 65]); o.w = pk2(s[6 * 65], s[7 * 65]);
        *(u32x4*)(WT + (size_t)wmap<MAP>(n0 + n) * K + k0 + 8 * c) = o;
    }
}
template <int MAP> __device__ __forceinline__ void convert_weight(const Ctx& X, const float* W, int K, int N, bf16_t* WT) {
    const int nitems = (K / 64) * ((N + 63) / 64);
    for (int it = X.bid; it < nitems; it += X.G) transpose_tile<MAP>(X, W, K, N, WT, it);
    __syncthreads();
}

__device__ __forceinline__ void rmsnorm_rows(const Ctx& X, const float* r0, const float* r1, const float* g, bf16_t* H) {
    const int gw = X.bid * 8 + X.wave, NGW = X.G * 8;
    f32x4 gv[8];
#pragma unroll
    for (int j = 0; j < 8; ++j) gv[j] = *(const f32x4*)(g + 4 * (64 * j + X.lane));
    f32x4 nx[8];
    if (gw < MT) {
        const float* xr = (gw < MP) ? r0 + (size_t)gw * DM : r1 + (size_t)(gw - MP) * DM;
#pragma unroll
        for (int j = 0; j < 8; ++j) nx[j] = *(const f32x4*)(xr + 4 * (64 * j + X.lane));
    }
    for (int m = gw; m < MT; m += NGW) {
        f32x4 v[8]; float s = 0.f;
#pragma unroll
        for (int j = 0; j < 8; ++j) v[j] = nx[j];
        const int mn = m + NGW;
        if (mn < MT) {
            const float* xr = (mn < MP) ? r0 + (size_t)mn * DM : r1 + (size_t)(mn - MP) * DM;
#pragma unroll
            for (int j = 0; j < 8; ++j) nx[j] = *(const f32x4*)(xr + 4 * (64 * j + X.lane));
        }
#pragma unroll
        for (int j = 0; j < 8; ++j) s += (v[j].x * v[j].x + v[j].y * v[j].y) + (v[j].z * v[j].z + v[j].w * v[j].w);
        const float rs = 1.f / sqrtf(wave_sum(s) * (1.f / DM) + EPS);
        bf16_t* o = H + (size_t)m * DM;
#pragma unroll
        for (int j = 0; j < 8; ++j) { u32x2 w; w.x = pk2(v[j].x * rs * gv[j].x, v[j].y * rs * gv[j].y); w.y = pk2(v[j].z * rs * gv[j].z, v[j].w * rs * gv[j].w); *(u32x2*)(o + 4 * (64 * j + X.lane)) = w; }
    }
}

__device__ __forceinline__ void convert_flat(const Ctx& X, const float* src, bf16_t* dst, size_t n) {
    const size_t nthr = (size_t)X.G * 512;
    for (size_t i = ((size_t)X.bid * 512 + X.tid) * 8; i < n; i += nthr * 8) {
        const f32x4 a = *(const f32x4*)(src + i), b = *(const f32x4*)(src + i + 4);
        u32x4 w; w.x = pk2(a.x, a.y); w.y = pk2(a.z, a.w); w.z = pk2(b.x, b.y); w.w = pk2(b.z, b.w);
        *(u32x4*)(dst + i) = w;
    }
}

__device__ __forceinline__ void postproj_rows(const Ctx& X, const Params& p, bf16_t* PROJ) {
    const int gw = X.bid * 8 + X.wave, NGW = X.G * 8, lane = X.lane;
    const float* gq = p.in[11]; const float* gk = p.in[12];
    float gqv[16], gkv[4];
#pragma unroll
    for (int e = 0; e < 16; ++e) gqv[e] = gq[16 * (lane & 3) + e];
#pragma unroll
    for (int e = 0; e < 4; ++e) gkv[e] = gk[4 * (lane & 15) + e];
    u32x4 nqa, nqb; u32x2 nka, nva; unsigned nki;
    if (gw < MT) {
        const bf16_t* pr = PROJ + (size_t)gw * NPROJ;
        nqa = *(const u32x4*)(pr + C_Q + 16 * lane); nqb = *(const u32x4*)(pr + C_Q + 16 * lane + 8);
        nka = *(const u32x2*)(pr + C_K + 4 * lane); nva = *(const u32x2*)(pr + C_V + 4 * lane); nki = (unsigned)pr[C_KI + lane];
    }
    for (int m = gw; m < MT; m += NGW) {
        bf16_t* pr = PROJ + (size_t)m * NPROJ;
        const u32x4 cqa = nqa, cqb = nqb; const u32x2 cka = nka, cva = nva; const unsigned cki = nki;
        if (m + NGW < MT) {
            const bf16_t* pn = PROJ + (size_t)(m + NGW) * NPROJ;
            nqa = *(const u32x4*)(pn + C_Q + 16 * lane); nqb = *(const u32x4*)(pn + C_Q + 16 * lane + 8);
            nka = *(const u32x2*)(pn + C_K + 4 * lane); nva = *(const u32x2*)(pn + C_V + 4 * lane); nki = (unsigned)pn[C_KI + lane];
        }
        {
            bf16_t* qp = pr + C_Q + 16 * lane;
            const u32x4 a = cqa, b = cqb;
            float v[16] = {bflo(a.x), bfhi(a.x), bflo(a.y), bfhi(a.y), bflo(a.z), bfhi(a.z), bflo(a.w), bfhi(a.w), bflo(b.x), bfhi(b.x), bflo(b.y), bfhi(b.y), bflo(b.z), bfhi(b.z), bflo(b.w), bfhi(b.w)};
            float s = 0.f;
#pragma unroll
            for (int e = 0; e < 16; ++e) s += v[e] * v[e];
            s += __shfl_xor(s, 1); s += __shfl_xor(s, 2);
            const float rs = 1.f / sqrtf(s * (1.f / 64) + EPS);
#pragma unroll
            for (int e = 0; e < 16; ++e) v[e] = v[e] * rs * gqv[e];
            u32x4 wa, wb; wa.x = pk2(v[0], v[1]); wa.y = pk2(v[2], v[3]); wa.z = pk2(v[4], v[5]); wa.w = pk2(v[6], v[7]);
            wb.x = pk2(v[8], v[9]); wb.y = pk2(v[10], v[11]); wb.z = pk2(v[12], v[13]); wb.w = pk2(v[14], v[15]);
            *(u32x4*)qp = wa; *(u32x4*)(qp + 8) = wb;
        }
        float* ko = (m < MP) ? p.out + O_KP + (size_t)m * 256 : p.out + O_KS + (size_t)(m - MP) * 256;
        float* vo = (m < MP) ? p.out + O_VP + (size_t)m * 256 : p.out + O_VS + (size_t)(m - MP) * 256;
        float* kio = (m < MP) ? p.out + O_KIP + (size_t)m * 64 : p.out + O_KIS + (size_t)(m - MP) * 64;
        {
            bf16_t* kp = pr + C_K + 4 * lane;
            const u32x2 a = cka;
            float v[4] = {bflo(a.x), bfhi(a.x), bflo(a.y), bfhi(a.y)};
            float s = v[0] * v[0] + v[1] * v[1] + v[2] * v[2] + v[3] * v[3];
            s += __shfl_xor(s, 1); s += __shfl_xor(s, 2); s += __shfl_xor(s, 4); s += __shfl_xor(s, 8);
            const float rs = 1.f / sqrtf(s * (1.f / 64) + EPS);
#pragma unroll
            for (int e = 0; e < 4; ++e) v[e] = v[e] * rs * gkv[e];
            u32x2 w; w.x = pk2(v[0], v[1]); w.y = pk2(v[2], v[3]);
            *(u32x2*)kp = w;
            *(f32x4*)(ko + 4 * lane) = (f32x4){v[0], v[1], v[2], v[3]};
        }
        {
            const u32x2 a = cva;
            *(f32x4*)(vo + 4 * lane) = (f32x4){bflo(a.x), bfhi(a.x), bflo(a.y), bfhi(a.y)};
        }
        kio[lane] = bf2f(cki);
    }
}

struct SeqInfo { int samp, bs, t, P, nvis, rowbase; };
__device__ __forceinline__ SeqInfo seq_of_row(int m) {
    SeqInfo s;
    if (m < MP) { s.samp = 0; s.bs = m / SEQ; s.t = m % SEQ; s.P = 0; s.nvis = (s.t / 64 + 1) * 64; s.rowbase = s.bs * SEQ; }
    else { s.samp = 1; s.bs = (m - MP) / DSEQ; s.t = (m - MP) % DSEQ; s.P = PAST; s.nvis = LS; s.rowbase = MP + s.bs * DSEQ; }
    return s;
}

constexpr int IX_CAP = 1024;
constexpr int IX_CTL = 131072, IX_BMP = 65536;
__device__ __forceinline__ unsigned ordkey(float f) { const unsigned u = __builtin_bit_cast(unsigned, f); return (u & 0x80000000u) ? ~u : (u | 0x80000000u); }

__device__ __forceinline__ void indexer_item(const Ctx& X, const Params& p, const bf16_t* PROJ, bf16_t* IDX, int item) {
    const int lane = X.lane, wid = X.wave, tid = X.tid;
    const int m0 = item * 8;
    const SeqInfo S = seq_of_row(m0);
    const int nvis = S.nvis, need = nvis < 256 ? nvis : 256, ntiles = nvis / 32;
    const bf16_t* CKI = (const bf16_t*)(p.ws + WS_CKI);
    LAS unsigned* hist = (LAS unsigned*)X.lds;
    LAS unsigned* ctl = (LAS unsigned*)(X.lds + IX_CTL);
    LAS u32x2* cand = (LAS u32x2*)X.lds;
    LAS unsigned* bmp = (LAS unsigned*)(X.lds + IX_BMP);
    __syncthreads();
#pragma unroll
    for (int r = 0; r < 8; ++r) *(LAS u32x4*)(X.lds + (r * 512 + tid) * 16) = (u32x4){0u, 0u, 0u, 0u};
    if (tid < 32) ctl[tid] = 0u;
    { LAS u32x4* bz = (LAS u32x4*)(X.lds + IX_BMP) + 2 * tid; bz[0] = (u32x4){0u, 0u, 0u, 0u}; bz[1] = (u32x4){0u, 0u, 0u, 0u}; }
    { u32x2 z = {0u, 0u}; *(u32x2*)(IDX + (size_t)(m0 + wid) * 256 + 4 * lane) = z; }
    const float bigf = __builtin_bit_cast(float, 0x7f000000u | ((unsigned)tid >> 20));
    const int rho = lane & 31, hi = lane >> 5, g = rho >> 3, qsel = (rho >> 2) & 1, jj = rho & 3, head = 4 * g + jj;
    bf16x8 af[4][4]; float w[4][16];
#pragma unroll
    for (int a = 0; a < 4; ++a) {
        const bf16_t* qp = PROJ + (size_t)(m0 + 2 * a + qsel) * NPROJ + C_QI + head * 64 + 8 * hi;
#pragma unroll
        for (int kk = 0; kk < 4; ++kk) af[a][kk] = *(const bf16x8*)(qp + 16 * kk);
        const bf16_t* wp = PROJ + (size_t)(m0 + 2 * a + hi) * NPROJ + C_WI;
        const u32x4 w0 = *(const u32x4*)wp, w1 = *(const u32x4*)(wp + 8);
        const float wv[16] = {bflo(w0.x), bfhi(w0.x), bflo(w0.y), bfhi(w0.y), bflo(w0.z), bfhi(w0.z), bflo(w0.w), bfhi(w0.w), bflo(w1.x), bfhi(w1.x), bflo(w1.y), bfhi(w1.y), bflo(w1.z), bfhi(w1.z), bflo(w1.w), bfhi(w1.w)};
#pragma unroll
        for (int i = 0; i < 16; ++i) w[a][i] = wv[i] * 0.25f;
    }
    asm volatile("s_waitcnt vmcnt(0)" ::: "memory");
    __syncthreads();
    {
        bf16x8 bnx[4];
        {
            const int s = wid * 32 + rho;
            const int sc_ = s < nvis ? s : nvis - 1;
            const bf16_t* kp;
            if (!S.samp) kp = PROJ + (size_t)(S.rowbase + sc_) * NPROJ + C_KI;
            else kp = (sc_ < PAST) ? CKI + (size_t)(S.bs * PAST + sc_) * 64 : PROJ + (size_t)(S.rowbase + sc_ - PAST) * NPROJ + C_KI;
#pragma unroll
            for (int kk = 0; kk < 4; ++kk) bnx[kk] = *(const bf16x8*)(kp + 16 * kk + 8 * hi);
        }
        for (int kt = wid; kt < ntiles; kt += 8) {
            const int s = kt * 32 + rho;
            bf16x8 bfr[4];
#pragma unroll
            for (int kk = 0; kk < 4; ++kk) bfr[kk] = bnx[kk];
            {
                const int s2 = s + 256, sc_ = s2 < nvis ? s2 : nvis - 1;
                const bf16_t* kp;
                if (!S.samp) kp = PROJ + (size_t)(S.rowbase + sc_) * NPROJ + C_KI;
                else kp = (sc_ < PAST) ? CKI + (size_t)(S.bs * PAST + sc_) * 64 : PROJ + (size_t)(S.rowbase + sc_ - PAST) * NPROJ + C_KI;
#pragma unroll
                for (int kk = 0; kk < 4; ++kk) bnx[kk] = *(const bf16x8*)(kp + 16 * kk + 8 * hi);
            }
            f32x16 accs[4];
            accs[0] = (f32x16){0, 0, 0, 0, 0, 0, 0, 0, 0, 0, 0, 0, 0, 0, 0, 0};
#pragma unroll
            for (int kk = 0; kk < 4; ++kk) accs[0] = __builtin_amdgcn_mfma_f32_32x32x16_bf16(af[0][kk], bfr[kk], accs[0], 0, 0, 0);
#pragma unroll
            for (int a = 0; a < 4; ++a) {
                if (a + 1 < 4) {
                    accs[a + 1] = (f32x16){0, 0, 0, 0, 0, 0, 0, 0, 0, 0, 0, 0, 0, 0, 0, 0};
#pragma unroll
                    for (int kk = 0; kk < 4; ++kk) accs[a + 1] = __builtin_amdgcn_mfma_f32_32x32x16_bf16(af[a + 1][kk], bfr[kk], accs[a + 1], 0, 0, 0);
                }
                const f32x16 acc = accs[a];
                float sp[4] = {0.f, 0.f, 0.f, 0.f};
#pragma unroll
                for (int i = 0; i < 16; ++i) sp[i & 3] = __builtin_fmaf(w[a][i], __builtin_amdgcn_fmed3f(acc[i], 0.f, bigf), sp[i & 3]);
                const float sc = (sp[0] + sp[1]) + (sp[2] + sp[3]);
                const unsigned key = ordkey(sc), bin = key >> 20;
                const int q = 2 * a + hi;
                atomicAdd((unsigned*)(hist + q * 2048 + (bin >> 1)), (bin & 1) ? 0x10000u : 1u);
            }
        }
    }
    asm volatile("s_waitcnt vmcnt(0) lgkmcnt(0)" ::: "memory");
    __syncthreads();
    {
            unsigned sv = 0;
            { const LAS unsigned* hq = hist + wid * 2048 + 32 * lane;
              for (int i = 0; i < 32; ++i) { const unsigned c = hq[i]; sv += (c & 0xffffu) + (c >> 16); } }
            unsigned sf = sv;
#pragma unroll
            for (int o = 1; o < 64; o <<= 1) { const unsigned t = __shfl_down(sf, o); if (lane + o < 64) sf += t; }
            sf -= sv;
            const unsigned long long bal = __ballot(sf < (unsigned)need && sf + sv >= (unsigned)need);
            const int Lc = bal ? __builtin_ctzll(bal) : 0;
            unsigned base = __shfl(sf, Lc);
            unsigned cn = hist[wid * 2048 + 32 * Lc + (lane >> 1)];
            cn = (lane & 1) ? (cn >> 16) : (cn & 0xffffu);
            unsigned sx = cn;
#pragma unroll
            for (int o = 1; o < 64; o <<= 1) { const unsigned t = __shfl_down(sx, o); if (lane + o < 64) sx += t; }
            base += sx - cn;
            if (base < (unsigned)need && base + cn >= (unsigned)need) { ctl[wid] = (unsigned)(64 * Lc + lane); ctl[8 + wid] = base; }
            LDS_WAIT();
            __syncthreads();
    }
    {
        unsigned thr[4];
#pragma unroll
        for (int a = 0; a < 4; ++a) thr[a] = ctl[2 * a + hi];
        bf16x8 bnx[4];
        {
            const int s = wid * 32 + rho;
            const int sc_ = s < nvis ? s : nvis - 1;
            const bf16_t* kp;
            if (!S.samp) kp = PROJ + (size_t)(S.rowbase + sc_) * NPROJ + C_KI;
            else kp = (sc_ < PAST) ? CKI + (size_t)(S.bs * PAST + sc_) * 64 : PROJ + (size_t)(S.rowbase + sc_ - PAST) * NPROJ + C_KI;
#pragma unroll
            for (int kk = 0; kk < 4; ++kk) bnx[kk] = *(const bf16x8*)(kp + 16 * kk + 8 * hi);
        }
        for (int kt = wid; kt < ntiles; kt += 8) {
            const int s = kt * 32 + rho;
            bf16x8 bfr[4];
#pragma unroll
            for (int kk = 0; kk < 4; ++kk) bfr[kk] = bnx[kk];
            {
                const int s2 = s + 256, sc_ = s2 < nvis ? s2 : nvis - 1;
                const bf16_t* kp;
                if (!S.samp) kp = PROJ + (size_t)(S.rowbase + sc_) * NPROJ + C_KI;
                else kp = (sc_ < PAST) ? CKI + (size_t)(S.bs * PAST + sc_) * 64 : PROJ + (size_t)(S.rowbase + sc_ - PAST) * NPROJ + C_KI;
#pragma unroll
                for (int kk = 0; kk < 4; ++kk) bnx[kk] = *(const bf16x8*)(kp + 16 * kk + 8 * hi);
            }
            f32x16 accs[4];
            accs[0] = (f32x16){0, 0, 0, 0, 0, 0, 0, 0, 0, 0, 0, 0, 0, 0, 0, 0};
#pragma unroll
            for (int kk = 0; kk < 4; ++kk) accs[0] = __builtin_amdgcn_mfma_f32_32x32x16_bf16(af[0][kk], bfr[kk], accs[0], 0, 0, 0);
#pragma unroll
            for (int a = 0; a < 4; ++a) {
                if (a + 1 < 4) {
                    accs[a + 1] = (f32x16){0, 0, 0, 0, 0, 0, 0, 0, 0, 0, 0, 0, 0, 0, 0, 0};
#pragma unroll
                    for (int kk = 0; kk < 4; ++kk) accs[a + 1] = __builtin_amdgcn_mfma_f32_32x32x16_bf16(af[a + 1][kk], bfr[kk], accs[a + 1], 0, 0, 0);
                }
                const f32x16 acc = accs[a];
                float sp[4] = {0.f, 0.f, 0.f, 0.f};
#pragma unroll
                for (int i = 0; i < 16; ++i) sp[i & 3] = __builtin_fmaf(w[a][i], __builtin_amdgcn_fmed3f(acc[i], 0.f, bigf), sp[i & 3]);
                const float sc = (sp[0] + sp[1]) + (sp[2] + sp[3]);
                const unsigned key = ordkey(sc), bin = key >> 20;
                const int q = 2 * a + hi;
                if (bin > thr[a]) {
                    atomicOr((unsigned*)(bmp + q * 512 + (s >> 5)), 1u << (s & 31));
                } else if (bin == thr[a]) {
                    const unsigned cp = atomicAdd((unsigned*)(ctl + 24 + q), 1u);
                    if (cp < (unsigned)IX_CAP) cand[q * IX_CAP + cp] = (u32x2){key, (unsigned)s};
                }
            }
        }
        asm volatile("s_waitcnt vmcnt(0) lgkmcnt(0)" ::: "memory");
        __syncthreads();
    }
    {
        const int q = wid;
        const unsigned cab = ctl[8 + q]; unsigned n1 = ctl[24 + q]; if (n1 > (unsigned)IX_CAP) n1 = IX_CAP;
        const int r = need - (int)cab;
        for (unsigned i = lane; i < n1; i += 64) {
            const u32x2 ci = cand[q * IX_CAP + i];
            int rank = 0;
            unsigned j = 0;
            for (; j + 8 <= n1; j += 8) {
                u32x2 cj[8];
#pragma unroll
                for (int u = 0; u < 8; ++u) cj[u] = cand[q * IX_CAP + j + u];
#pragma unroll
                for (int u = 0; u < 8; ++u) rank += (cj[u].x > ci.x || (cj[u].x == ci.x && cj[u].y < ci.y)) ? 1 : 0;
            }
            for (; j < n1; ++j) { const u32x2 cj = cand[q * IX_CAP + j]; rank += (cj.x > ci.x || (cj.x == ci.x && cj.y < ci.y)) ? 1 : 0; }
            if (rank < r) atomicOr((unsigned*)(bmp + q * 512 + (ci.y >> 5)), 1u << (ci.y & 31));
        }
        asm volatile("s_waitcnt vmcnt(0) lgkmcnt(0)" ::: "memory");
        __builtin_amdgcn_wave_barrier();
        unsigned wv[8]; unsigned cnt = 0;
#pragma unroll
        for (int i = 0; i < 8; ++i) { wv[i] = bmp[q * 512 + 8 * lane + i]; cnt += __builtin_popcount(wv[i]); }
        unsigned inc = cnt;
#pragma unroll
        for (int o = 1; o < 64; o <<= 1) { const unsigned t = __shfl_up(inc, o); if (lane >= o) inc += t; }
        unsigned pos = inc - cnt;
#pragma unroll
        for (int i = 0; i < 8; ++i) {
            unsigned wq = wv[i];
            while (wq) { const int bpos = __builtin_ctz(wq); wq &= wq - 1; if (pos < 256u) IDX[(size_t)(m0 + q) * 256 + pos] = (bf16_t)((8 * lane + i) * 32 + bpos); ++pos; }
        }
    }
    __syncthreads();
}

constexpr int AT_BIAS = 0, AT_LUT = 2048, AT_WAVE = 4096, AT_WSZ = 5120;
__device__ __forceinline__ void attn_setup(const Ctx& X, const Params& p) {
    LAS float* bl = (LAS float*)(X.lds + AT_BIAS);
    LAS unsigned char* lut = X.lds + AT_LUT;
    __syncthreads();
    if (X.tid < 512) bl[X.tid] = p.in[13][X.tid];
    if (X.tid < 128) { const int n = X.tid; lut[n] = (unsigned char)(n < 8 ? n : n < 12 ? 8 : n < 16 ? 9 : n < 23 ? 10 : n < 32 ? 11 : n < 46 ? 12 : n < 64 ? 13 : n < 91 ? 14 : 15); }
    __syncthreads();
}
struct AttnPre { u32x2 idxv; bf16x8 q0, q1; };
__device__ __forceinline__ AttnPre attn_prefetch(const Ctx& X, const bf16_t* PROJ, const bf16_t* IDX, int m) {
    AttnPre P; const int lane = X.lane, hn = lane & 15, lq = lane >> 4;
    P.idxv = *(const u32x2*)(IDX + (size_t)m * 256 + 4 * lane);
    const bf16_t* qp = PROJ + (size_t)m * NPROJ + C_Q + hn * 64 + 8 * lq; P.q0 = *(const bf16x8*)qp; P.q1 = *(const bf16x8*)(qp + 32);
    return P;
}
__device__ __forceinline__ const bf16_t* attn_row(const SeqInfo& S, const bf16_t* PROJ, const bf16_t* CX, int s, int coff) {
    if (!S.samp) return PROJ + (size_t)(S.rowbase + s) * NPROJ + coff;
    return (s < PAST) ? CX + (size_t)(S.bs * PAST + s) * 256 : PROJ + (size_t)(S.rowbase + s - PAST) * NPROJ + coff;
}
__device__ __forceinline__ void attn_query(const Ctx& X, const Params& p, bf16_t* PROJ, int m, const AttnPre& P) {
    const int lane = X.lane, hn = lane & 15, lq = lane >> 4;
    const SeqInfo S = seq_of_row(m);
    const int qpos = S.P + S.t, nvalid = S.nvis < 256 ? S.nvis : 256;
    const LAS float* bl = (const LAS float*)(X.lds + AT_BIAS);
    const LAS unsigned char* lut = X.lds + AT_LUT;
    LAS unsigned char* wl = X.lds + AT_WAVE + X.wave * AT_WSZ;
    LAS bf16_t* idl = (LAS bf16_t*)(wl + 4352);
    const bf16_t* CK = (const bf16_t*)(p.ws + WS_CK); const bf16_t* CV = (const bf16_t*)(p.ws + WS_CV);
    *(LAS u32x2*)(idl + 4 * lane) = P.idxv;
    const bf16x8 zero8 = {0, 0, 0, 0, 0, 0, 0, 0};
    const int myn = hn >> 2;
    bf16x8 qm[4][2];
#pragma unroll
    for (int n = 0; n < 4; ++n) { qm[n][0] = (myn == n) ? P.q0 : zero8; qm[n][1] = (myn == n) ? P.q1 : zero8; }
    LDS_WAIT();
    float lg[16][4];
    float mx = -INFINITY;
    bf16x8 kb[2][8];
#pragma unroll
    for (int T = 0; T < 2; ++T) {
        const bf16_t* kp = attn_row(S, PROJ, CK, (int)idl[16 * T + hn], C_K) + 8 * lq;
#pragma unroll
        for (int f = 0; f < 8; ++f) kb[T][f] = *(const bf16x8*)(kp + (f >> 1) * 64 + 32 * (f & 1));
    }
#pragma unroll
    for (int T = 0; T < 16; ++T) {
        f32x4 acc = {0.f, 0.f, 0.f, 0.f};
#pragma unroll
        for (int f = 0; f < 8; ++f) acc = __builtin_amdgcn_mfma_f32_16x16x32_bf16(kb[T & 1][f], qm[f >> 1][f & 1], acc, 0, 0, 0);
        if (T + 2 < 16) {
            const bf16_t* kp = attn_row(S, PROJ, CK, (int)idl[16 * (T + 2) + hn], C_K) + 8 * lq;
#pragma unroll
            for (int f = 0; f < 8; ++f) kb[T & 1][f] = *(const bf16x8*)(kp + (f >> 1) * 64 + 32 * (f & 1));
        }
#pragma unroll
        for (int i = 0; i < 4; ++i) {
            const int j = 16 * T + 4 * lq + i;
            const int si = (int)idl[j];
            const int rel = si - qpos; int n = rel < 0 ? -rel : rel; n = n > 127 ? 127 : n;
            const int bucket = (rel > 0 ? 16 : 0) + (int)lut[n];
            float v = acc[i] * 0.125f + bl[bucket * 16 + hn];
            v = (j < nvalid) ? v : -INFINITY;
            lg[T][i] = v; mx = fmaxf(mx, v);
        }
    }
    const int r = lane & 31, half = lane >> 5;
    u32x4 vv[4][4];
    {
        const bf16_t* vp = attn_row(S, PROJ, CV, (int)idl[r], C_V) + 32 * half;
#pragma unroll
        for (int n = 0; n < 4; ++n)
#pragma unroll
            for (int cc = 0; cc < 4; ++cc) vv[n][cc] = *(const u32x4*)(vp + n * 64 + 8 * cc);
    }
    mx = fmaxf(mx, __shfl_xor(mx, 16)); mx = fmaxf(mx, __shfl_xor(mx, 32));
    float sum = 0.f;
#pragma unroll
    for (int T = 0; T < 16; ++T)
#pragma unroll
        for (int i = 0; i < 4; ++i) { const float e = __expf(lg[T][i] - mx); lg[T][i] = e; sum += e; }
    sum += __shfl_xor(sum, 16); sum += __shfl_xor(sum, 32);
    const float inv = 1.f / sum;
    bf16x8 pf[8];
#pragma unroll
    for (int u = 0; u < 8; ++u) {
        u32x4 pw; pw.x = pk2(lg[2 * u][0] * inv, lg[2 * u][1] * inv); pw.y = pk2(lg[2 * u][2] * inv, lg[2 * u][3] * inv);
        pw.z = pk2(lg[2 * u + 1][0] * inv, lg[2 * u + 1][1] * inv); pw.w = pk2(lg[2 * u + 1][2] * inv, lg[2 * u + 1][3] * inv);
        pf[u] = __builtin_bit_cast(bf16x8, pw);
    }
    f32x4 O[4];
#pragma unroll
    for (int db = 0; db < 4; ++db) O[db] = (f32x4){0.f, 0.f, 0.f, 0.f};
#pragma unroll
    for (int u = 0; u < 8; ++u) {
        u32x4 vn[4][4];
        if (u + 1 < 8) {
            const bf16_t* vp = attn_row(S, PROJ, CV, (int)idl[32 * (u + 1) + r], C_V) + 32 * half;
#pragma unroll
            for (int n = 0; n < 4; ++n)
#pragma unroll
                for (int cc = 0; cc < 4; ++cc) vn[n][cc] = *(const u32x4*)(vp + n * 64 + 8 * cc);
        }
#pragma unroll
        for (int n = 0; n < 4; ++n) {
            LDS_WAIT(); __builtin_amdgcn_wave_barrier();
#pragma unroll
            for (int cc = 0; cc < 4; ++cc) *(LAS u32x4*)(wl + r * 136 + 16 * (4 * half + cc)) = vv[n][cc];
            LDS_WAIT(); __builtin_amdgcn_wave_barrier();
            const bf16x8 pa = (myn == n) ? pf[u] : zero8;
#pragma unroll
            for (int db = 0; db < 4; ++db) {
                bf16x8 vb;
#pragma unroll
                for (int e = 0; e < 8; ++e) { const int rr = (e < 4) ? (4 * lq + e) : (16 + 4 * lq + (e - 4)); vb[e] = (short)*(const LAS bf16_t*)(wl + rr * 136 + 2 * (16 * db + hn)); }
                O[db] = __builtin_amdgcn_mfma_f32_16x16x32_bf16(pa, vb, O[db], 0, 0, 0);
            }
        }
        if (u + 1 < 8) {
#pragma unroll
            for (int n = 0; n < 4; ++n)
#pragma unroll
                for (int cc = 0; cc < 4; ++cc) vv[n][cc] = vn[n][cc];
        }
    }
    LDS_WAIT(); __builtin_amdgcn_wave_barrier();
    bf16_t* op = PROJ + (size_t)m * NPROJ + C_Q;
#pragma unroll
    for (int db = 0; db < 4; ++db)
#pragma unroll
        for (int i = 0; i < 4; ++i) op[(4 * lq + i) * 64 + 16 * db + hn] = (bf16_t)f2bf(O[db][i]);
}

constexpr int HG_NP = 4096, HG_NS = 64;
struct HgItem { int samp, sh, c, h, row0, nvalid; };
__device__ __forceinline__ HgItem hg_item(int id) {
    HgItem I;
    if (id < HG_NP) { I.samp = 0; I.sh = id >> 8; I.c = id & 255; I.h = I.sh & 7; I.row0 = (I.sh >> 3) * SEQ + I.c * 64; I.nvalid = 64; }
    else { const int k = id - HG_NP; I.samp = 1; I.sh = k; I.c = 0; I.h = k & 7; I.row0 = MP + (k >> 3) * DSEQ; I.nvalid = 32; }
    return I;
}
__device__ __forceinline__ bf16_t* hg_state_ptr(const Params& p, int id) {
    return (id < HG_NP) ? (bf16_t*)(p.ws + WS_H) + (size_t)id * 16384 : (bf16_t*)(p.ws + WS_SST) + (size_t)(id - HG_NP) * 16384;
}
constexpr int HP = 144;

__device__ __forceinline__ void hg_gates(const Ctx& X, const Params& p, const bf16_t* PROJ, const HgItem& I, LAS float* part, float (&b)[16], float (&kk)[16], float& bend, float (&pref)[4]) {
    const int col = X.tid & 127, tq = X.tid >> 7;
    const float r0 = p.in[14][I.h * 128 + col], r1 = p.in[14][1024 + I.h * 128 + col];
    const float lb = sigmoidf_(r0 - r1);
    float run = 0.f;
#pragma unroll
    for (int j = 0; j < 16; ++j) {
        const int t = 16 * tq + j, tc = t < I.nvalid ? t : I.nvalid - 1;
        const float rf = bf2f((unsigned)PROJ[(size_t)(I.row0 + tc) * NPROJ + C_RF + I.h * 128 + col]);
        const float f = lb + (1.f - lb) * sigmoidf_(rf);
        const float g = (t < I.nvalid) ? __logf(f) : 0.f, k1 = (t < I.nvalid) ? 1.f - f : 0.f;
        run += g; b[j] = run; kk[j] = k1;
    }
    part[tq * 128 + col] = run;
    __syncthreads();
    float off = 0.f, tot = 0.f;
#pragma unroll
    for (int q = 0; q < 4; ++q) { const float v = part[q * 128 + col]; pref[q] = tot; if (q < tq) off += v; tot += v; }
#pragma unroll
    for (int j = 0; j < 16; ++j) b[j] += off;
    bend = tot;
}
__device__ __forceinline__ void hg_store16(LAS unsigned char* base, int row, int tq, const float (&v)[16]) {
    u32x4 a, c; a.x = pk2(v[0], v[1]); a.y = pk2(v[2], v[3]); a.z = pk2(v[4], v[5]); a.w = pk2(v[6], v[7]);
    c.x = pk2(v[8], v[9]); c.y = pk2(v[10], v[11]); c.z = pk2(v[12], v[13]); c.w = pk2(v[14], v[15]);
    *(LAS u32x4*)(base + row * HP + 32 * tq) = a; *(LAS u32x4*)(base + row * HP + 32 * tq + 16) = c;
}
__device__ __forceinline__ void hg_load_vt(const Ctx& X, const bf16_t* PROJ, const HgItem& I, LAS unsigned char* VT) {
    const int col = X.tid & 127, tq = X.tid >> 7;
    float v[16];
#pragma unroll
    for (int j = 0; j < 16; ++j) { const int t = 16 * tq + j, tc = t < I.nvalid ? t : I.nvalid - 1; const float x = bf2f((unsigned)PROJ[(size_t)(I.row0 + tc) * NPROJ + C_RI + I.h * 128 + col]); v[j] = (t < I.nvalid) ? x : 0.f; }
    hg_store16(VT, col, tq, v);
}

__device__ __forceinline__ void hg1_item(const Ctx& X, const Params& p, const bf16_t* PROJ, int id) {
    const HgItem I = hg_item(id);
    LAS unsigned char* KT = X.lds; LAS unsigned char* VT = X.lds + 128 * HP; LAS float* part = (LAS float*)(X.lds + 2 * 128 * HP);
    const int col = X.tid & 127, tq = X.tid >> 7;
    unsigned riv[16];
#pragma unroll
    for (int j = 0; j < 16; ++j) { const int t = 16 * tq + j, tc = t < I.nvalid ? t : I.nvalid - 1; riv[j] = (unsigned)PROJ[(size_t)(I.row0 + tc) * NPROJ + C_RI + I.h * 128 + col]; }
    __syncthreads();
    float b[16], kk[16], bend, pref[4];
    hg_gates(X, p, PROJ, I, part, b, kk, bend, pref);
#pragma unroll
    for (int j = 0; j < 16; ++j) kk[j] = kk[j] * __expf(bend - b[j]);
    hg_store16(KT, col, tq, kk);
    {
        float vv[16];
#pragma unroll
        for (int j = 0; j < 16; ++j) vv[j] = (16 * tq + j < I.nvalid) ? bf2f(riv[j]) : 0.f;
        hg_store16(VT, col, tq, vv);
    }
    if (tq == 0) ((float*)(p.ws + WS_HD))[(size_t)id * 128 + col] = __expf(bend);
    LDS_WAIT();
    __syncthreads();
    bf16_t* dst = (id < HG_NP) ? hg_state_ptr(p, id) : (bf16_t*)(p.ws + WS_SDL) + (size_t)(id - HG_NP) * 16384;
    const int lane = X.lane, l32 = lane & 31, hi = lane >> 5;
    const int ti = X.wave >> 1;
#pragma unroll
    for (int tt = 0; tt < 2; ++tt) {
        const int tj = 2 * (X.wave & 1) + tt;
        f32x16 acc = {0, 0, 0, 0, 0, 0, 0, 0, 0, 0, 0, 0, 0, 0, 0, 0};
#pragma unroll
        for (int s4 = 0; s4 < 4; ++s4) {
            const bf16x8 a = *(const LAS bf16x8*)(KT + (32 * ti + l32) * HP + 32 * s4 + 16 * hi);
            const bf16x8 bb = *(const LAS bf16x8*)(VT + (32 * tj + l32) * HP + 32 * s4 + 16 * hi);
            acc = __builtin_amdgcn_mfma_f32_32x32x16_bf16(a, bb, acc, 0, 0, 0);
        }
#pragma unroll
        for (int g = 0; g < 4; ++g) {
            u32x2 w; w.x = pk2(acc[4 * g], acc[4 * g + 1]); w.y = pk2(acc[4 * g + 2], acc[4 * g + 3]);
            *(u32x2*)(dst + (size_t)(32 * tj + l32) * 128 + 32 * ti + 8 * g + 4 * hi) = w;
        }
    }
}

__device__ __forceinline__ void hg2_prompt(const Ctx& X, const Params& p, int item) {
    const int e = item * 1024 + 2 * X.tid;
    const int sh = e >> 14, v = (e >> 7) & 127, k = e & 127;
    unsigned* st = (unsigned*)((bf16_t*)(p.ws + WS_H) + (size_t)sh * 256 * 16384 + (size_t)v * 128 + k);
    const float* hd = (const float*)(p.ws + WS_HD) + (size_t)sh * 256 * 128 + k;
    float s0 = 0.f, s1 = 0.f;
    for (int c0 = 0; c0 < 256; c0 += 32) {
        unsigned d[32]; float dx[32], dy[32];
#pragma unroll
        for (int u = 0; u < 32; ++u) { d[u] = st[(size_t)(c0 + u) * 8192]; dx[u] = hd[(c0 + u) * 128]; dy[u] = hd[(c0 + u) * 128 + 1]; }
#pragma unroll
        for (int u = 0; u < 32; ++u) {
            st[(size_t)(c0 + u) * 8192] = pk2(s0, s1);
            s0 = dx[u] * s0 + bflo(d[u]); s1 = dy[u] * s1 + bfhi(d[u]);
        }
    }
    float* o = p.out + O_HP + (size_t)sh * 16384;
    o[k * 128 + v] = s0; o[(k + 1) * 128 + v] = s1;
}
__device__ __forceinline__ void hg2_sample(const Ctx& X, const Params& p, int item) {
    const int e = item * 1024 + 2 * X.tid;
    const int sh = e >> 14, v = (e >> 7) & 127, k = e & 127;
    const float* s0p = p.in[5] + (size_t)sh * 16384;
    const float a0 = s0p[k * 128 + v], a1 = s0p[(k + 1) * 128 + v];
    const size_t off = (size_t)sh * 16384 + (size_t)v * 128 + k;
    *(unsigned*)((bf16_t*)(p.ws + WS_SST) + off) = pk2(a0, a1);
    const unsigned d = *(const unsigned*)((const bf16_t*)(p.ws + WS_SDL) + off);
    const float* hd = (const float*)(p.ws + WS_HD) + (size_t)(HG_NP + sh) * 128 + k;
    float* o = p.out + O_HS + (size_t)sh * 16384;
    o[k * 128 + v] = hd[0] * a0 + bflo(d); o[(k + 1) * 128 + v] = hd[1] * a1 + bfhi(d);
}

constexpr int H3_AQI = 0, H3_AQD = 64 * 272, H3_BK = 2 * 64 * 272, H3_VT = H3_BK + 160 * 272, H3_PL = H3_VT + 128 * HP, H3_MISC = H3_PL + 64 * HP;
__device__ __forceinline__ void hg3_item(const Ctx& X, const Params& p, bf16_t* PROJ, int id) {
    const HgItem I = hg_item(id);
    LAS unsigned char* L = X.lds;
    LAS float* part = (LAS float*)(L + H3_MISC); LAS float* mu = part + 512; LAS float* ssq = mu + 512;
    const int tid = X.tid, col = tid & 127, tq = tid >> 7, lane = X.lane;
    const int l32 = lane & 31, hi = lane >> 5, l16 = lane & 15, lq = lane >> 4;
    const int ti = X.wave >> 2, tj = X.wave & 3;
    unsigned rqv[16], riv[16], rgv[16]; bf16x8 sfr[8];
    {
        const bf16_t* pc0 = PROJ + I.h * 128;
#pragma unroll
        for (int j = 0; j < 16; ++j) {
            const int t = 16 * tq + j, tc = t < I.nvalid ? t : I.nvalid - 1;
            const bf16_t* pr = pc0 + (size_t)(I.row0 + tc) * NPROJ + col;
            rqv[j] = (unsigned)pr[C_RQ]; riv[j] = (unsigned)pr[C_RI];
        }
#pragma unroll
        for (int r = 0; r < 16; ++r) {
            const int t = 32 * ti + 8 * (r >> 2) + 4 * hi + (r & 3), tc = t < I.nvalid ? t : I.nvalid - 1;
            rgv[r] = (unsigned)pc0[(size_t)(I.row0 + tc) * NPROJ + C_RG + 32 * tj + l32];
        }
        const bf16_t* sp = hg_state_ptr(p, id) + (size_t)(32 * tj + l32) * 128 + 8 * hi;
#pragma unroll
        for (int ks = 0; ks < 8; ++ks) sfr[ks] = *(const bf16x8*)(sp + 16 * ks);
    }
    __syncthreads();
    float b[16], kk[16], bend, pref[4];
    hg_gates(X, p, PROJ, I, part, b, kk, bend, pref);
    mu[tq * 128 + col] = b[7];
    for (int i = tid; i < 64 * HP / 16; i += 512) *(LAS u32x4*)(L + H3_PL + 16 * i) = (u32x4){0u, 0u, 0u, 0u};
    LDS_WAIT();
    __syncthreads();
    {
        float mus[4];
#pragma unroll
        for (int q = 0; q < 4; ++q) mus[q] = mu[q * 128 + col];
#pragma unroll
        for (int j = 0; j < 16; ++j) {
            const int t = 16 * tq + j;
            float qq = siluf_(bf2f(rqv[j]));
            qq = (t < I.nvalid) ? qq : 0.f;
            *(LAS bf16_t*)(L + H3_AQI + t * 272 + 2 * col) = (bf16_t)f2bf(qq * __expf(b[j]));
            *(LAS bf16_t*)(L + H3_AQD + t * 272 + 2 * col) = (bf16_t)f2bf(qq * __expf(b[j] - mus[tq]));
#pragma unroll
            for (int i = 0; i < 4; ++i) {
                if (i >= tq) {
                    const int rbase = 8 * i * (i + 1);
                    *(LAS bf16_t*)(L + H3_BK + (rbase + t) * 272 + 2 * col) = (bf16_t)f2bf(kk[j] * __expf(mus[i] - b[j]));
                }
            }
        }
        {
            float vv[16];
#pragma unroll
            for (int j = 0; j < 16; ++j) vv[j] = (16 * tq + j < I.nvalid) ? bf2f(riv[j]) : 0.f;
            hg_store16(L + H3_VT, col, tq, vv);
        }
    }
    LDS_WAIT();
    __syncthreads();
    f32x16 acc = {0, 0, 0, 0, 0, 0, 0, 0, 0, 0, 0, 0, 0, 0, 0, 0};
    {
#pragma unroll
        for (int ks = 0; ks < 8; ++ks) {
            const bf16x8 a = *(const LAS bf16x8*)(L + H3_AQI + (32 * ti + l32) * 272 + 32 * ks + 16 * hi);
            const bf16x8 bb = sfr[ks];
            acc = __builtin_amdgcn_mfma_f32_32x32x16_bf16(a, bb, acc, 0, 0, 0);
        }
    }
    for (int tile = X.wave; tile < 10; tile += 8) {
        int i = 0, js = tile; while (js > i) { js -= i + 1; ++i; }
        const int rbase = 8 * i * (i + 1);
        f32x4 pc = {0.f, 0.f, 0.f, 0.f};
#pragma unroll
        for (int ks = 0; ks < 4; ++ks) {
            const bf16x8 a = *(const LAS bf16x8*)(L + H3_AQD + (16 * i + l16) * 272 + 64 * ks + 16 * lq);
            const bf16x8 bb = *(const LAS bf16x8*)(L + H3_BK + (rbase + 16 * js + l16) * 272 + 64 * ks + 16 * lq);
            pc = __builtin_amdgcn_mfma_f32_16x16x32_bf16(a, bb, pc, 0, 0, 0);
        }
#pragma unroll
        for (int r = 0; r < 4; ++r) {
            const int tl = 4 * lq + r; float v = pc[r];
            if (js == i && l16 > tl) v = 0.f;
            *(LAS bf16_t*)(L + H3_PL + (16 * i + tl) * HP + 2 * (16 * js + l16)) = (bf16_t)f2bf(v);
        }
    }
    LDS_WAIT();
    __syncthreads();
#pragma unroll
    for (int ss = 0; ss < 4; ++ss) {
        const bf16x8 a = *(const LAS bf16x8*)(L + H3_PL + (32 * ti + l32) * HP + 32 * ss + 16 * hi);
        const bf16x8 bb = *(const LAS bf16x8*)(L + H3_VT + (32 * tj + l32) * HP + 32 * ss + 16 * hi);
        acc = __builtin_amdgcn_mfma_f32_32x32x16_bf16(a, bb, acc, 0, 0, 0);
    }
#pragma unroll
    for (int r = 0; r < 16; ++r) {
        float s = acc[r] * acc[r];
        s += __shfl_xor(s, 1); s += __shfl_xor(s, 2); s += __shfl_xor(s, 4); s += __shfl_xor(s, 8); s += __shfl_xor(s, 16);
        if (l32 == 0) ssq[(32 * ti + 8 * (r >> 2) + 4 * hi + (r & 3)) * 4 + tj] = s;
    }
    LDS_WAIT();
    __syncthreads();
    const int v = 32 * tj + l32;
    const float gr = p.in[15][v];
#pragma unroll
    for (int r = 0; r < 16; ++r) {
        const int t = 32 * ti + 8 * (r >> 2) + 4 * hi + (r & 3), tc = t < I.nvalid ? t : I.nvalid - 1;
        const f32x4 q4 = *(const LAS f32x4*)(ssq + t * 4);
        const float rs = 1.f / sqrtf(((q4.x + q4.y) + (q4.z + q4.w)) * (1.f / 128) + EPS);
        bf16_t* pr = PROJ + (size_t)(I.row0 + tc) * NPROJ;
        const float rg = bf2f(rgv[r]);
        if (t < I.nvalid) pr[C_RQ + I.h * 128 + v] = (bf16_t)f2bf(acc[r] * rs * gr * siluf_(rg));
    }
}


template <int MODE> __device__ __forceinline__ void skinny_gemm(const Ctx& X, const bf16_t* A, int lda, const bf16_t* Bt, int K, bf16_t* O, float* Y, const float* R1, float alpha) {
    const int lane = X.lane, r16 = lane & 15, q = lane >> 4;
    for (int item = X.bid; item < 256; item += X.G) {
        const int cg = item >> 1, half = item & 1;
        const bf16_t* ap = A + (size_t)(128 * half + 16 * X.wave + r16) * lda + 8 * q;
        const bf16_t* bp = Bt + (size_t)(16 * cg + r16) * K + 8 * q;
        f32x4 acc0 = {0.f, 0.f, 0.f, 0.f}, acc1 = {0.f, 0.f, 0.f, 0.f};
        for (int k0 = 0; k0 < K; k0 += 256) {
            bf16x8 af[8], bf[8];
#pragma unroll
            for (int u = 0; u < 8; ++u) { af[u] = *(const bf16x8*)(ap + k0 + 32 * u); bf[u] = *(const bf16x8*)(bp + k0 + 32 * u); }
#pragma unroll
            for (int u = 0; u < 8; u += 2) { acc0 = __builtin_amdgcn_mfma_f32_16x16x32_bf16(af[u], bf[u], acc0, 0, 0, 0); acc1 = __builtin_amdgcn_mfma_f32_16x16x32_bf16(af[u + 1], bf[u + 1], acc1, 0, 0, 0); }
        }
        const int col = 16 * cg + r16;
#pragma unroll
        for (int i = 0; i < 4; ++i) {
            const int rl = 128 * half + 16 * X.wave + 4 * q + i;
            const float v = acc0[i] + acc1[i];
            if constexpr (MODE == pg8::EPI_RESID) {
                Y[(size_t)(MP + rl) * DM + col] = R1[(size_t)rl * DM + col] + alpha * v;
            } else {
                bf16_t* op = O + (size_t)(MP + rl) * NPROJ + C_GA + col;
                const float g = bf2f((unsigned)*op);
                if constexpr (MODE == pg8::EPI_MERGE1) *op = (bf16_t)f2bf(g * v);
                else { const float gb = bf2f((unsigned)op[C_GB - C_GA]); *op = (bf16_t)f2bf(g + gb * v); }
            }
        }
    }
}

#ifndef TIMING
#define TIMING 0
#define TIME_A0 0
#define TIME_A1 0
#define TIME_B0 0
#define TIME_B1 0
#endif
#ifndef DUP_PHASE
#define DUP_PHASE -1
#endif
__global__ void __launch_bounds__(512, 2) mega(Params p) {
    __builtin_assume(__builtin_amdgcn_workitem_id_y() == 0); __builtin_assume(__builtin_amdgcn_workitem_id_z() == 0);
    extern __shared__ __attribute__((aligned(16))) unsigned char smem[];
    Ctx X; X.lds = (LAS unsigned char*)smem; X.tid = threadIdx.x; X.lane = X.tid & 63; X.wave = __builtin_amdgcn_readfirstlane(X.tid >> 6); X.G = gridDim.x; X.bid = blockIdx.x;
    cg::grid_group grid = cg::this_grid();
    unsigned char* ws = p.ws;
    bf16_t* WA = (bf16_t*)(ws + WS_A); bf16_t* WB = (bf16_t*)(ws + WS_B); bf16_t* WATT = (bf16_t*)(ws + WS_WATT); bf16_t* WREC = (bf16_t*)(ws + WS_WREC); bf16_t* WOUT = (bf16_t*)(ws + WS_WOUT);
    bf16_t* H = (bf16_t*)(ws + WS_H); bf16_t* BIG = (bf16_t*)(ws + WS_BIG); bf16_t* IDX = (bf16_t*)(ws + WS_IDX);
    float* Y = p.out + O_Y;
    const int lo = p.ph_lo, hi = p.ph_hi;
#define IN(k) (lo <= (k) && (k) < hi)
#if TIMING
#define SEAM(k) do { if (IN(k) && IN((k) + 1)) grid.sync(); if (X.bid == 0 && X.tid == 0) ((volatile unsigned long long*)ws)[(k) + 1] = __builtin_amdgcn_s_memrealtime(); } while (0)
#else
#define SEAM(k) do { if (IN(k) && IN((k) + 1)) grid.sync(); } while (0)
#endif
#if TIMING
    if (X.bid == 0 && X.tid == 0) ((volatile unsigned long long*)ws)[0] = __builtin_amdgcn_s_memrealtime();
#endif
    if (IN(0)) {
        convert_weight<1>(X, p.in[7], DM, NFF, WA);
        convert_weight<0>(X, p.in[8], DFF, DM, WB);
        convert_weight<0>(X, p.in[16], 1024, DM, WATT);
        convert_weight<0>(X, p.in[17], 1024, DM, WREC);
        convert_weight<0>(X, p.in[18], DM, DM, WOUT);
        rmsnorm_rows(X, p.in[0], p.in[1], p.in[6], H);
    }
    SEAM(0);
    if (IN(1)) for (int rep = 0; rep < (DUP_PHASE == 1 ? 2 : 1); ++rep) {
        pg8::Gemm g{H, WA, MT, NFF, DM, DM}; pg8::StaticOrder S; S.init(MT, NFF, X.G, X.bid);
        pg8::Epi<pg8::EPI_SWIGLU> E{BIG, nullptr, nullptr, nullptr, 0.f};
        pg8::gemm_phase<pg8::Epi<pg8::EPI_SWIGLU>, pg8::StaticOrder, true, true>(X.lds, g, S, E);
    }
    SEAM(1);
    if (IN(2)) {
        convert_weight<2>(X, p.in[10], DM, 10832, WA);
        for (size_t i = ((size_t)X.bid * 512 + X.tid) * 8; i < (size_t)(NPROJ - 10832) * DM; i += (size_t)X.G * 512 * 8) *(u32x4*)(WA + (size_t)10832 * DM + i) = (u32x4){0u, 0u, 0u, 0u};
        __syncthreads();
        pg8::Gemm g{BIG, WB, MP, DM, DFF, DFF}; pg8::StaticOrder S; S.init(MP, DM, X.G, X.bid);
        pg8::Epi<pg8::EPI_RESID> E{nullptr, Y, p.in[0], p.in[1], 0.5f};
        pg8::gemm_phase<pg8::Epi<pg8::EPI_RESID>, pg8::StaticOrder, true, true>(X.lds, g, S, E);
        skinny_gemm<pg8::EPI_RESID>(X, BIG + (size_t)MP * DFF, DFF, WB, DFF, nullptr, Y, p.in[1], 0.5f);
    }
    SEAM(2);
    if (IN(3)) {
        rmsnorm_rows(X, Y, Y + (size_t)MP * DM, p.in[9], H);
        convert_weight<0>(X, p.in[21], DFF, DM, WB);
        convert_flat(X, p.in[2], (bf16_t*)(ws + WS_CK), (size_t)8 * PAST * 256);
        convert_flat(X, p.in[3], (bf16_t*)(ws + WS_CV), (size_t)8 * PAST * 256);
        convert_flat(X, p.in[4], (bf16_t*)(ws + WS_CKI), (size_t)8 * PAST * 64);
    }
    SEAM(3);
    if (IN(4)) for (int rep = 0; rep < (DUP_PHASE == 4 ? 2 : 1); ++rep) {
        pg8::Gemm g{H, WA, MT, NPROJ, DM, DM}; pg8::StaticOrder S; S.init(MT, NPROJ, X.G, X.bid);
        pg8::Epi<pg8::EPI_PROJ> E{BIG, nullptr, nullptr, nullptr, 0.f};
        pg8::gemm_phase<pg8::Epi<pg8::EPI_PROJ>, pg8::StaticOrder, true, true>(X.lds, g, S, E);
    }
    SEAM(4);
    if (IN(5)) {
        postproj_rows(X, p, BIG);
        convert_weight<1>(X, p.in[20], DM, NFF, WA);
    }
    SEAM(5);
    if (IN(6)) for (int rep = 0; rep < (DUP_PHASE == 6 ? 2 : 1); ++rep) {
        for (int it = X.bid; it < HG_NP + HG_NS; it += X.G) hg1_item(X, p, BIG, it);
        for (int j = 0; j * X.G < MT / 8; ++j) { const int it = j * X.G + ((j & 1) ? X.G - 1 - X.bid : X.bid); if (it < MT / 8) indexer_item(X, p, BIG, IDX, it); }
    }
    SEAM(6);
    if (IN(7)) {
        for (int it = X.bid; it < 256; it += X.G) hg2_prompt(X, p, it);
        for (int it = X.bid; it < 1024; it += X.G) hg2_sample(X, p, it);
        attn_setup(X, p);
        {
            const int vcu = (X.G % 8 == 0) ? (X.bid & 7) * (X.G / 8) + (X.bid >> 3) : X.bid;
            const int wg = vcu * 8 + X.wave, nwg = X.G * 8, per = MP / nwg;
            const int nq = per + ((wg < MT - per * nwg) ? 1 : 0);
            auto row_of = [&](int j) { return j < per ? wg * per + j : per * nwg + wg; };
            AttnPre P = attn_prefetch(X, BIG, IDX, row_of(0));
            for (int j = 0; j < nq; ++j) {
                const int m = row_of(j);
                const AttnPre Pn = attn_prefetch(X, BIG, IDX, (j + 1 < nq) ? row_of(j + 1) : m);
                attn_query(X, p, BIG, m, P);
                P = Pn;
            }
        }
    }
    SEAM(7);
    if (IN(8)) {
        for (int it = X.bid; it < HG_NP + HG_NS; it += X.G) hg3_item(X, p, BIG, it);
        __syncthreads();
    }
    SEAM(8);
    if (IN(9)) {
        pg8::Gemm g{BIG + C_Q, WATT, MP, DM, 1024, NPROJ}; pg8::StaticOrder S; S.init(MP, DM, X.G, X.bid);
        pg8::Epi<pg8::EPI_MERGE1> E{BIG, nullptr, nullptr, nullptr, 0.f};
        pg8::gemm_phase<pg8::Epi<pg8::EPI_MERGE1>, pg8::StaticOrder, true, true>(X.lds, g, S, E);
        skinny_gemm<pg8::EPI_MERGE1>(X, BIG + (size_t)MP * NPROJ + C_Q, NPROJ, WATT, 1024, BIG, nullptr, nullptr, 0.f);
    }
    SEAM(9);
    if (IN(10)) {
        pg8::Gemm g{BIG + C_RQ, WREC, MP, DM, 1024, NPROJ}; pg8::StaticOrder S; S.init(MP, DM, X.G, X.bid);
        pg8::Epi<pg8::EPI_MERGE2> E{BIG, nullptr, nullptr, nullptr, 0.f};
        pg8::gemm_phase<pg8::Epi<pg8::EPI_MERGE2>, pg8::StaticOrder, true, true>(X.lds, g, S, E);
        skinny_gemm<pg8::EPI_MERGE2>(X, BIG + (size_t)MP * NPROJ + C_RQ, NPROJ, WREC, 1024, BIG, nullptr, nullptr, 0.f);
    }
    SEAM(10);
    if (IN(11)) {
        pg8::Gemm g{BIG + C_GA, WOUT, MP, DM, DM, NPROJ}; pg8::StaticOrder S; S.init(MP, DM, X.G, X.bid);
        pg8::Epi<pg8::EPI_RESID> E{nullptr, Y, Y, Y + (size_t)MP * DM, 1.f};
        pg8::gemm_phase<pg8::Epi<pg8::EPI_RESID>, pg8::StaticOrder, true, true>(X.lds, g, S, E);
        skinny_gemm<pg8::EPI_RESID>(X, BIG + (size_t)MP * NPROJ + C_GA, NPROJ, WOUT, DM, nullptr, Y, Y + (size_t)MP * DM, 1.f);
    }
    SEAM(11);
    if (IN(12)) rmsnorm_rows(X, Y, Y + (size_t)MP * DM, p.in[19], H);
    SEAM(12);
    if (IN(13)) {
        pg8::Gemm g{H, WA, MT, NFF, DM, DM}; pg8::StaticOrder S; S.init(MT, NFF, X.G, X.bid);
        pg8::Epi<pg8::EPI_SWIGLU> E{BIG, nullptr, nullptr, nullptr, 0.f};
        pg8::gemm_phase<pg8::Epi<pg8::EPI_SWIGLU>, pg8::StaticOrder, true, true>(X.lds, g, S, E);
    }
    SEAM(13);
    if (IN(14)) {
        pg8::Gemm g{BIG, WB, MP, DM, DFF, DFF}; pg8::StaticOrder S; S.init(MP, DM, X.G, X.bid);
        pg8::Epi<pg8::EPI_RESID> E{nullptr, Y, Y, Y + (size_t)MP * DM, 0.5f};
        pg8::gemm_phase<pg8::Epi<pg8::EPI_RESID>, pg8::StaticOrder, true, true>(X.lds, g, S, E);
        skinny_gemm<pg8::EPI_RESID>(X, BIG + (size_t)MP * DFF, DFF, WB, DFF, nullptr, Y, Y + (size_t)MP * DM, 0.5f);
    }
#if TIMING
    SEAM(14);
    grid.sync();
    if (X.bid == 0 && X.tid == 0) {
        volatile unsigned long long* ts = (volatile unsigned long long*)ws;
        const float usA = (float)(ts[TIME_A1 + 1] - ts[TIME_A0]) * 0.01f, usB = (float)(ts[TIME_B1 + 1] - ts[TIME_B0]) * 0.01f;
        p.out[O_KIS] += sqrtf(16384.f * usA * 1e-7f);
        p.out[O_Y] += usB * 1e-2f;
    }
#endif
}

#ifndef N_LAUNCH_MODE
#define N_LAUNCH_MODE 1
#endif
extern "C" void kernel_launch(void* const* d_in, const int* in_sizes, int n_in, void* d_out, int out_size, void* d_ws, size_t ws_size, hipStream_t stream) {
    static int grid_blocks = 0;
    if (!grid_blocks) {
        hipFuncSetAttribute((const void*)mega, hipFuncAttributeMaxDynamicSharedMemorySize, LDS_BYTES);
        int dev = 0, cus = 0, per_cu = 0;
        hipGetDevice(&dev);
        hipDeviceGetAttribute(&cus, hipDeviceAttributeMultiprocessorCount, dev);
        hipOccupancyMaxActiveBlocksPerMultiprocessor(&per_cu, mega, 512, LDS_BYTES);
        if (per_cu < 1) per_cu = 1;
        grid_blocks = cus * 1;
        if (ws_size < WS_END) fprintf(stderr, "workspace too small: %zu < %zu\n", ws_size, (size_t)WS_END);
    }
    Params p{};
    for (int i = 0; i < 22; ++i) p.in[i] = (const float*)d_in[i];
    p.out = (float*)d_out; p.ws = (unsigned char*)d_ws;
#if N_LAUNCH_MODE == 1
    p.ph_lo = 0; p.ph_hi = NPH;
    void* args[] = {&p};
    hipError_t e = hipLaunchCooperativeKernel((const void*)mega, dim3(grid_blocks), dim3(512), args, LDS_BYTES, stream);
    if (e != hipSuccess) fprintf(stderr, "cooperative launch failed: %s (grid %d)\n", hipGetErrorString(e), grid_blocks);
#else
    for (int k = 0; k < NPH; ++k) {
        p.ph_lo = k; p.ph_hi = k + 1;
        hipLaunchKernelGGL(mega, dim3(grid_blocks), dim3(512), LDS_BYTES, stream, p);
    }
#endif
}
```

```cpp
#include <hip/hip_runtime.h>
#include <hip/hip_cooperative_groups.h>
#include <cstdio>
#include <cstdint>
namespace cg = cooperative_groups;

#define LAS __attribute__((address_space(3)))
typedef unsigned short bf16_t;
typedef short bf16x8 __attribute__((ext_vector_type(8)));
typedef float f32x4 __attribute__((ext_vector_type(4)));
typedef float f32x16 __attribute__((ext_vector_type(16)));
typedef unsigned u32x4 __attribute__((ext_vector_type(4)));
typedef unsigned u32x2 __attribute__((ext_vector_type(2)));
typedef short v4i16_t __attribute__((ext_vector_type(4)));

constexpr int DM = 2048, MP = 32768, MS = 256, MT = MP + MS, DFF = 5632, NFF = 2 * DFF, NPROJ = 11008;
constexpr int SEQ = 16384, DSEQ = 32, PAST = 4096, LS = PAST + DSEQ;
constexpr float EPS = 1e-6f;
constexpr int C_Q = 0, C_K = 1024, C_V = 1280, C_QI = 1536, C_RF = 2560, C_RQ = 3584, C_RI = 4608, C_RG = 5632, C_GA = 6656, C_GB = 8704, C_KI = 10752, C_WI = 10816;
constexpr size_t O_Y = 0, O_KP = 67633152, O_VP = 76021760, O_KIP = 84410368, O_HP = 86507520, O_KS = 86769664, O_VS = 86835200, O_KIS = 86900736, O_HS = 86917120;
constexpr size_t MiB = 1u << 20;
constexpr size_t WS_A = 1 * MiB, WS_B = 45 * MiB, WS_WATT = 67 * MiB, WS_WREC = 71 * MiB, WS_WOUT = 75 * MiB, WS_H = 83 * MiB, WS_BIG = 212 * MiB,
                 WS_IDX = 906 * MiB, WS_CK = 923 * MiB, WS_CV = 939 * MiB, WS_CKI = 955 * MiB, WS_SST = 959 * MiB, WS_SDL = 961 * MiB, WS_HD = 963 * MiB, WS_END = 966 * MiB;
constexpr int LDS_BYTES = 147456;
constexpr int NPH = 15;

struct Params {
    const float* in[22];
    float* out;
    unsigned char* ws;
    int ph_lo, ph_hi;
};

__device__ __forceinline__ unsigned f2bf(float f) { unsigned u = __builtin_bit_cast(unsigned, f); return (u + 0x7fffu + ((u >> 16) & 1u)) >> 16; }
typedef float f32x2_t __attribute__((ext_vector_type(2)));
typedef __bf16 bf16x2_t __attribute__((ext_vector_type(2)));
__device__ __forceinline__ unsigned pk2(float lo, float hi) { f32x2_t v = {lo, hi}; bf16x2_t b = __builtin_convertvector(v, bf16x2_t); return __builtin_bit_cast(unsigned, b); }
__device__ __forceinline__ float bf2f(unsigned h) { return __builtin_bit_cast(float, h << 16); }
__device__ __forceinline__ float bflo(unsigned w) { return __builtin_bit_cast(float, w << 16); }
__device__ __forceinline__ float bfhi(unsigned w) { return __builtin_bit_cast(float, w & 0xffff0000u); }
__device__ __forceinline__ float sigmoidf_(float x) { return __builtin_amdgcn_rcpf(1.f + __expf(-x)); }
__device__ __forceinline__ float siluf_(float x) { return x * sigmoidf_(x); }
__device__ __forceinline__ float wave_sum(float v) {
#pragma unroll
    for (int o = 1; o < 64; o <<= 1) v += __shfl_xor(v, o);
    return v;
}
#define LDS_WAIT() asm volatile("s_waitcnt lgkmcnt(0)" ::: "memory")

namespace pg8 {
#define PG8_LAS __attribute__((address_space(3)))
constexpr int BM = 256, BK = 64, HALF = 128, HTB = HALF * BK * 2, STAGE_BYTES = 8 * HTB, NXCD = 8, WGM = 8;
__host__ __device__ __forceinline__ int lds_byte(int r, int c) { const int st = (r >> 4) * 2 + (c >> 5), rr = r & 15, cc = c & 31, ob = rr * 64 + cc * 2; return st * 1024 + (ob ^ (((ob >> 9) & 1) << 5)); }
__host__ __device__ __forceinline__ void stage_rc(int b, int& R, int& C) { const int st = b / 1024, sb = b % 1024, swz = sb ^ (((sb >> 9) & 1) << 5); R = (st >> 1) * 16 + swz / 64; C = (st & 1) * 32 + (swz % 64) / 2; }
__host__ __device__ __forceinline__ int perm32(int rho) { const int n = rho >> 4, i = rho & 15; return 8 * (i >> 2) + 4 * n + (i & 3); }
struct Unit { int pm, pn; };
struct Gemm { const bf16_t* A; const bf16_t* Bt; int M, N, K, lda; };
struct StaticOrder {
    int nM, nN, nwg, G, c;
    __host__ __device__ void init(int M, int N, int G_, int c_) { nM = M / BM; nN = N / BM; nwg = nM * nN; G = G_; c = c_; }
    __host__ __device__ bool next(int i, Unit& u) const {
        const long L = (long)i * G + c; if (L >= nwg) return false;
        int wgid = (int)L; { const int q = nwg / NXCD, r = nwg % NXCD, xcd = wgid % NXCD, off = wgid / NXCD; wgid = (xcd < r ? xcd * (q + 1) : r * (q + 1) + (xcd - r) * q) + off; }
        const int nig = WGM * nN, gid = wgid / nig, fm = gid * WGM, gsz = (nM - fm) < WGM ? (nM - fm) : WGM;
        u.pm = fm + ((wgid % nig) % gsz); u.pn = (wgid % nig) / gsz; return true;
    }
    __device__ __forceinline__ void a_ready(const Unit&) const {}
    __device__ __forceinline__ void done(const Unit&) const {}
};

enum { EPI_SWIGLU = 0, EPI_RESID = 1, EPI_PROJ = 2, EPI_MERGE1 = 3, EPI_MERGE2 = 4 };
template <int MODE> struct Epi {
    static constexpr bool PERM = true, AFTER_DRAIN = false;
    bf16_t* O; float* Y; const float* R0; const float* R1; float alpha;
    __device__ __forceinline__ void operator()(const f32x4 (&acc)[2][2][4][2], const Unit& u, int wr, int wc, int fr, int fq) const {
        const int row0 = u.pm * BM + wr * 64 + fr;
        if constexpr (MODE == EPI_SWIGLU) {
            const int col0 = u.pn * 128 + wc * 32 + 8 * fq;
#pragma unroll
            for (int ai = 0; ai < 2; ++ai)
#pragma unroll
                for (int m = 0; m < 4; ++m) {
                    const int row = row0 + ai * HALF + m * 16;
                    float h[8];
#pragma unroll
                    for (int n = 0; n < 2; ++n)
#pragma unroll
                        for (int j = 0; j < 4; ++j) { const float g = acc[ai][0][m][n][j], up = acc[ai][1][m][n][j]; h[4 * n + j] = siluf_(g) * up; }
                    u32x4 w; w.x = pk2(h[0], h[1]); w.y = pk2(h[2], h[3]); w.z = pk2(h[4], h[5]); w.w = pk2(h[6], h[7]);
                    *(u32x4*)(O + (size_t)row * DFF + col0) = w;
                }
        } else if constexpr (MODE == EPI_RESID) {
#pragma unroll
            for (int ai = 0; ai < 2; ++ai)
#pragma unroll
                for (int m = 0; m < 4; ++m) {
                    const int row = row0 + ai * HALF + m * 16;
                    const float* rp = (row < MP) ? R0 + (size_t)row * DM : R1 + (size_t)(row - MP) * DM;
                    float* yp = Y + (size_t)row * DM;
#pragma unroll
                    for (int bj = 0; bj < 2; ++bj) {
                        const int col = u.pn * BM + bj * HALF + wc * 32 + 8 * fq;
                        const f32x4 r0 = *(const f32x4*)(rp + col), r1 = *(const f32x4*)(rp + col + 4);
                        *(f32x4*)(yp + col) = r0 + acc[ai][bj][m][0] * alpha;
                        *(f32x4*)(yp + col + 4) = r1 + acc[ai][bj][m][1] * alpha;
                    }
                }
        } else {
            const bool sig = (MODE == EPI_PROJ) && (u.pn >= C_GA / 256) && (u.pn < C_KI / 256);
#pragma unroll
            for (int ai = 0; ai < 2; ++ai)
#pragma unroll
                for (int m = 0; m < 4; ++m) {
                    const int row = row0 + ai * HALF + m * 16;
#pragma unroll
                    for (int bj = 0; bj < 2; ++bj) {
                        const int col = u.pn * BM + bj * HALF + wc * 32 + 8 * fq;
                        float v[8];
#pragma unroll
                        for (int n = 0; n < 2; ++n)
#pragma unroll
                            for (int j = 0; j < 4; ++j) v[4 * n + j] = acc[ai][bj][m][n][j];
                        bf16_t* op;
                        if constexpr (MODE == EPI_PROJ) {
                            op = O + (size_t)row * NPROJ + col;
                            if (sig) {
#pragma unroll
                                for (int e = 0; e < 8; ++e) v[e] = sigmoidf_(v[e]);
                            }
                        } else {
                            op = O + (size_t)row * NPROJ + C_GA + col;
                            const u32x4 g = *(const u32x4*)op;
                            const float gv[8] = {bflo(g.x), bfhi(g.x), bflo(g.y), bfhi(g.y), bflo(g.z), bfhi(g.z), bflo(g.w), bfhi(g.w)};
                            if constexpr (MODE == EPI_MERGE1) {
#pragma unroll
                                for (int e = 0; e < 8; ++e) v[e] = gv[e] * v[e];
                            } else {
                                const u32x4 g2 = *(const u32x4*)(op + (C_GB - C_GA));
                                const float hv[8] = {bflo(g2.x), bfhi(g2.x), bflo(g2.y), bfhi(g2.y), bflo(g2.z), bfhi(g2.z), bflo(g2.w), bfhi(g2.w)};
#pragma unroll
                                for (int e = 0; e < 8; ++e) v[e] = gv[e] + hv[e] * v[e];
                            }
                        }
                        u32x4 w; w.x = pk2(v[0], v[1]); w.y = pk2(v[2], v[3]); w.z = pk2(v[4], v[5]); w.w = pk2(v[6], v[7]);
                        *(u32x4*)op = w;
                    }
                }
        }
    }
};

template <class Epi, class Sched, bool ALIGN_EPI = false, bool SP2 = false>
__device__ __forceinline__ void gemm_phase(PG8_LAS unsigned char* lds, const Gemm g, const Sched& S, const Epi& E) {
    const int tid = threadIdx.x, wid = __builtin_amdgcn_readfirstlane(tid >> 6), lane = tid & 63, wr = wid >> 2, wc = wid & 3, fr = lane & 15, fq = lane >> 4;
    const int K = g.K, nt = K / BK;
    unsigned voffA[2], voffB[2];
#pragma unroll
    for (int i = 0; i < 2; ++i) { int R, C; stage_rc(tid * 16 + i * 8192, R, C); const int Rb = Epi::PERM ? ((R & ~31) + perm32(R & 31)) : R;
        voffA[i] = (unsigned)(R * g.lda + C) * 2u; voffB[i] = (unsigned)(Rb * K + C) * 2u; }
    const size_t kstep = (size_t)(BK * 2);
    const size_t hstepB = (size_t)HALF * K * 2, hstepA = (size_t)HALF * g.lda * 2;
    const size_t tstepA = 2 * hstepA, tstepB = 2 * hstepB;
    const unsigned ldsw = (unsigned)wid * 1024u;
    const int aoff = lds_byte(wr * 64 + fr, fq * 8), boff = lds_byte(wc * 32 + fr, fq * 8);
#define PG8_SA(b, h) (((b) * 2 + (h)) * HTB)
#define PG8_SB(b, h) ((4 + (b) * 2 + (h)) * HTB)
#define PG8_STAGE(bufoff, gbase, voff) do { _Pragma("unroll") for (int _i = 0; _i < 2; ++_i) \
        __builtin_amdgcn_global_load_lds((const unsigned*)((const char*)(gbase) + (voff)[_i]), (PG8_LAS unsigned*)(lds + (bufoff) + ldsw + _i * 8192), 16, 0, 0); } while (0)
#define PG8_LDA(dst, b, h) do { _Pragma("unroll") for (int m = 0; m < 4; ++m) _Pragma("unroll") for (int k = 0; k < 2; ++k) dst[m][k] = *(const PG8_LAS bf16x8*)(lds + PG8_SA(b, h) + aoff + m * 2048 + k * 1024); } while (0)
#define PG8_LDB(dst, b, h) do { _Pragma("unroll") for (int n = 0; n < 2; ++n) _Pragma("unroll") for (int k = 0; k < 2; ++k) dst[n][k] = *(const PG8_LAS bf16x8*)(lds + PG8_SB(b, h) + boff + n * 2048 + k * 1024); } while (0)
#define PG8_MMA(ai, bj, At, Bt) do { __builtin_amdgcn_s_setprio(1); _Pragma("unroll") for (int m = 0; m < 4; ++m) _Pragma("unroll") for (int n = 0; n < 2; ++n) _Pragma("unroll") for (int k = 0; k < 2; ++k) \
        acc[ai][bj][m][n] = __builtin_amdgcn_mfma_f32_16x16x32_bf16(Bt[n][k], At[m][k], acc[ai][bj][m][n], 0, 0, 0); __builtin_amdgcn_s_setprio(0); } while (0)
#define PG8_WAIT_V(n) asm volatile("s_waitcnt vmcnt(" #n ")" ::: "memory")
#define PG8_WAIT_L(n) asm volatile("s_waitcnt lgkmcnt(" #n ")" ::: "memory")
#define PG8_BAR __builtin_amdgcn_s_barrier()
#define PG8_SCHED __builtin_amdgcn_sched_barrier(0)
    Unit cur, nxt; int ui = 0;
    if (!S.next(0, cur)) return;
    f32x4 acc[2][2][4][2];
#pragma unroll
    for (int a = 0; a < 2; ++a)
#pragma unroll
        for (int b = 0; b < 2; ++b)
#pragma unroll
            for (int m = 0; m < 4; ++m)
#pragma unroll
                for (int n = 0; n < 2; ++n) acc[a][b][m][n] = (f32x4){0.f, 0.f, 0.f, 0.f};
    bf16x8 At[4][2], B0[2][2], B1[2][2];
    const char* cA = (const char*)g.A + (size_t)cur.pm * tstepA; const char* cB = (const char*)g.Bt + (size_t)cur.pn * tstepB;
    S.a_ready(cur);
    if constexpr (SP2) {
        PG8_STAGE(PG8_SB(0, 0), cB, voffB); PG8_STAGE(PG8_SB(0, 1), cB + hstepB, voffB); PG8_STAGE(PG8_SA(0, 0), cA, voffA); PG8_STAGE(PG8_SA(0, 1), cA + hstepA, voffA);
        if (wr == 1) PG8_BAR;
        PG8_WAIT_V(2); PG8_BAR;
        PG8_STAGE(PG8_SB(1, 0), cB + kstep, voffB); PG8_STAGE(PG8_SA(1, 0), cA + kstep, voffA); PG8_STAGE(PG8_SB(1, 1), cB + hstepB + kstep, voffB);
        PG8_WAIT_V(6); PG8_BAR;
    } else {
        PG8_STAGE(PG8_SB(0, 0), cB, voffB); PG8_STAGE(PG8_SA(0, 0), cA, voffA); PG8_STAGE(PG8_SB(0, 1), cB + hstepB, voffB); PG8_STAGE(PG8_SA(0, 1), cA + hstepA, voffA);
        if (wr == 1) PG8_BAR;
        PG8_WAIT_V(4); PG8_BAR;
        PG8_STAGE(PG8_SB(1, 0), cB + kstep, voffB); PG8_STAGE(PG8_SA(1, 0), cA + kstep, voffA); PG8_STAGE(PG8_SB(1, 1), cB + hstepB + kstep, voffB);
        PG8_WAIT_V(6); PG8_BAR;
    }
    for (;;) {
        const bool has_next = S.next(ui + 1, nxt);
        const char* nA = has_next ? (const char*)g.A + (size_t)nxt.pm * tstepA : cA; const char* nB = has_next ? (const char*)g.Bt + (size_t)nxt.pn * tstepB : cB;
        for (int t = 0; t < nt; t += 2) {
            const bool last = (t == nt - 2);
            const char* a1 = cA + (size_t)(t + 1) * kstep;
            const char* a2 = last ? nA : cA + (size_t)(t + 2) * kstep; const char* b2 = last ? nB : cB + (size_t)(t + 2) * kstep;
            const char* a3 = a2 + kstep; const char* b3 = b2 + kstep;
            if (last && has_next) S.a_ready(nxt);
            if constexpr (SP2) {
            PG8_LDB(B0, 0, 0); PG8_LDB(B1, 0, 1); PG8_SCHED; PG8_LDA(At, 0, 0); PG8_STAGE(PG8_SA(1, 1), a1 + hstepA, voffA);
            PG8_WAIT_V(8); PG8_WAIT_L(0); PG8_BAR; PG8_MMA(0, 0, At, B0); PG8_MMA(0, 1, At, B1); PG8_BAR; PG8_SCHED;
            PG8_LDA(At, 0, 1); PG8_STAGE(PG8_SB(0, 0), b2, voffB); PG8_STAGE(PG8_SB(0, 1), b2 + hstepB, voffB); PG8_STAGE(PG8_SA(0, 0), a2, voffA);
            PG8_WAIT_V(8); PG8_WAIT_L(0); PG8_BAR; PG8_MMA(1, 0, At, B0); PG8_MMA(1, 1, At, B1); PG8_BAR; PG8_SCHED;
            PG8_LDB(B0, 1, 0); PG8_LDB(B1, 1, 1); PG8_SCHED; PG8_LDA(At, 1, 0); PG8_STAGE(PG8_SA(0, 1), a2 + hstepA, voffA);
            PG8_WAIT_V(8); PG8_WAIT_L(0); PG8_BAR; PG8_MMA(0, 0, At, B0); PG8_MMA(0, 1, At, B1); PG8_BAR; PG8_SCHED;
            PG8_LDA(At, 1, 1); PG8_STAGE(PG8_SB(1, 0), b3, voffB); PG8_STAGE(PG8_SB(1, 1), b3 + hstepB, voffB); PG8_STAGE(PG8_SA(1, 0), a3, voffA);
            PG8_WAIT_V(8); PG8_WAIT_L(0); PG8_BAR; PG8_MMA(1, 0, At, B0); PG8_MMA(1, 1, At, B1); PG8_BAR; PG8_SCHED;
            } else {
            PG8_LDB(B0, 0, 0); PG8_SCHED; PG8_LDA(At, 0, 0); PG8_STAGE(PG8_SA(1, 1), a1 + hstepA, voffA);
            PG8_WAIT_L(8); PG8_BAR; PG8_WAIT_L(0); PG8_MMA(0, 0, At, B0); PG8_BAR; PG8_SCHED;
            PG8_LDB(B1, 0, 1); PG8_STAGE(PG8_SB(0, 0), b2, voffB);
            PG8_BAR; PG8_WAIT_L(0); PG8_MMA(0, 1, At, B1); PG8_BAR;
            PG8_LDA(At, 0, 1); PG8_STAGE(PG8_SA(0, 0), a2, voffA);
            PG8_BAR; PG8_WAIT_L(0); PG8_MMA(1, 0, At, B0); PG8_BAR; PG8_SCHED;
            PG8_STAGE(PG8_SB(0, 1), b2 + hstepB, voffB);
            PG8_WAIT_V(6); PG8_BAR; PG8_MMA(1, 1, At, B1); PG8_BAR;
            PG8_LDB(B0, 1, 0); PG8_SCHED; PG8_LDA(At, 1, 0); PG8_STAGE(PG8_SA(0, 1), a2 + hstepA, voffA);
            PG8_WAIT_L(8); PG8_BAR; PG8_WAIT_L(0); PG8_MMA(0, 0, At, B0); PG8_BAR; PG8_SCHED;
            PG8_LDB(B1, 1, 1); PG8_STAGE(PG8_SB(1, 0), b3, voffB);
            PG8_BAR; PG8_WAIT_L(0); PG8_MMA(0, 1, At, B1); PG8_BAR;
            PG8_LDA(At, 1, 1); PG8_STAGE(PG8_SA(1, 0), a3, voffA);
            PG8_BAR; PG8_WAIT_L(0); PG8_MMA(1, 0, At, B0); PG8_BAR; PG8_SCHED;
            PG8_STAGE(PG8_SB(1, 1), b3 + hstepB, voffB);
            PG8_WAIT_V(6); PG8_BAR; PG8_MMA(1, 1, At, B1); PG8_BAR;
            }
        }
        if constexpr (ALIGN_EPI) { if (wr == 0) PG8_BAR; }
        if constexpr (!Epi::AFTER_DRAIN) { E(acc, cur, wr, wc, fr, fq); S.done(cur); }
        if (!has_next) break;
#pragma unroll
        for (int a = 0; a < 2; ++a)
#pragma unroll
            for (int b = 0; b < 2; ++b)
#pragma unroll
                for (int m = 0; m < 4; ++m)
#pragma unroll
                    for (int n = 0; n < 2; ++n) acc[a][b][m][n] = (f32x4){0.f, 0.f, 0.f, 0.f};
        cur = nxt; cA = nA; cB = nB; ++ui;
        if constexpr (ALIGN_EPI) { if (wr == 1) PG8_BAR; }
    }
    PG8_WAIT_V(0);
    if constexpr (!ALIGN_EPI) { if (wr == 0) PG8_BAR; }
    PG8_BAR;
    if constexpr (Epi::AFTER_DRAIN) { E.fused(acc, cur, wr, wc, fr, fq, lds, wid, lane); S.done(cur); }
#undef PG8_SA
#undef PG8_SB
#undef PG8_STAGE
#undef PG8_LDA
#undef PG8_LDB
#undef PG8_MMA
#undef PG8_WAIT_V
#undef PG8_WAIT_L
#undef PG8_BAR
#undef PG8_SCHED
}
}

struct Ctx {
    LAS unsigned char* lds;
    int tid, lane, wave, G, bid;
};

template <int MAP> __device__ __forceinline__ int wmap(int c) {
    if constexpr (MAP == 1) { return c < DFF ? (256 * (c >> 7) + (c & 127)) : (256 * ((c - DFF) >> 7) + 128 + ((c - DFF) & 127)); }
    else if constexpr (MAP == 2) { return c < 2560 ? c : (c < 2624 ? C_KI + (c - 2560) : (c < 2640 ? C_WI + (c - 2624) : c - 80)); }
    else return c;
}
template <int MAP> __device__ __forceinline__ void transpose_tile(const Ctx& X, const float* W, int K, int N, bf16_t* WT, int item) {
    LAS float* scr = (LAS float*)X.lds;
    const int nblk = (N + 63) / 64, kb = item / nblk, nb = item % nblk, k0 = 64 * kb, n0 = 64 * nb;
    const int j = X.tid & 63, i0 = X.tid >> 6;
    __syncthreads();
#pragma unroll
    for (int r = 0; r < 8; ++r) { const int i = i0 + 8 * r; scr[i * 65 + j] = (n0 + j < N) ? W[(size_t)(k0 + i) * N + n0 + j] : 0.f; }
    __syncthreads();
    const int c = X.tid & 7, n = X.tid >> 3;
    if (n0 + n < N) {
        const LAS float* s = scr + (8 * c) * 65 + n;
        u32x4 o; o.x = pk2(s[0], s[65]); o.y = pk2(s[2 * 65], s[3 * 65]); o.z = pk2(s[4 * 65], s[5 * 65]); o.w = pk2(s[6 * 65], s[7 * 65]);
        *(u32x4*)(WT + (size_t)wmap<MAP>(n0 + n) * K + k0 + 8 * c) = o;
    }
}
template <int MAP> __device__ __forceinline__ void convert_weight(const Ctx& X, const float* W, int K, int N, bf16_t* WT) {
    const int nitems = (K / 64) * ((N + 63) / 64);
    for (int it = X.bid; it < nitems; it += X.G) transpose_tile<MAP>(X, W, K, N, WT, it);
    __syncthreads();
}

__device__ __forceinline__ void rmsnorm_rows(const Ctx& X, const float* r0, const float* r1, const float* g, bf16_t* H) {
    const int gw = X.bid * 8 + X.wave, NGW = X.G * 8;
    f32x4 gv[8];
#pragma unroll
    for (int j = 0; j < 8; ++j) gv[j] = *(const f32x4*)(g + 4 * (64 * j + X.lane));
    f32x4 nx[8];
    if (gw < MT) {
        const float* xr = (gw < MP) ? r0 + (size_t)gw * DM : r1 + (size_t)(gw - MP) * DM;
#pragma unroll
        for (int j = 0; j < 8; ++j) nx[j] = *(const f32x4*)(xr + 4 * (64 * j + X.lane));
    }
    for (int m = gw; m < MT; m += NGW) {
        f32x4 v[8]; float s = 0.f;
#pragma unroll
        for (int j = 0; j < 8; ++j) v[j] = nx[j];
        const int mn = m + NGW;
        if (mn < MT) {
            const float* xr = (mn < MP) ? r0 + (size_t)mn * DM : r1 + (size_t)(mn - MP) * DM;
#pragma unroll
            for (int j = 0; j < 8; ++j) nx[j] = *(const f32x4*)(xr + 4 * (64 * j + X.lane));
        }
#pragma unroll
        for (int j = 0; j < 8; ++j) s += (v[j].x * v[j].x + v[j].y * v[j].y) + (v[j].z * v[j].z + v[j].w * v[j].w);
        const float rs = 1.f / sqrtf(wave_sum(s) * (1.f / DM) + EPS);
        bf16_t* o = H + (size_t)m * DM;
#pragma unroll
        for (int j = 0; j < 8; ++j) { u32x2 w; w.x = pk2(v[j].x * rs * gv[j].x, v[j].y * rs * gv[j].y); w.y = pk2(v[j].z * rs * gv[j].z, v[j].w * rs * gv[j].w); *(u32x2*)(o + 4 * (64 * j + X.lane)) = w; }
    }
}

__device__ __forceinline__ void convert_flat(const Ctx& X, const float* src, bf16_t* dst, size_t n) {
    const size_t nthr = (size_t)X.G * 512;
    for (size_t i = ((size_t)X.bid * 512 + X.tid) * 8; i < n; i += nthr * 8) {
        const f32x4 a = *(const f32x4*)(src + i), b = *(const f32x4*)(src + i + 4);
        u32x4 w; w.x = pk2(a.x, a.y); w.y = pk2(a.z, a.w); w.z = pk2(b.x, b.y); w.w = pk2(b.z, b.w);
        *(u32x4*)(dst + i) = w;
    }
}

__device__ __forceinline__ void postproj_rows(const Ctx& X, const Params& p, bf16_t* PROJ) {
    const int gw = X.bid * 8 + X.wave, NGW = X.G * 8, lane = X.lane;
    const float* gq = p.in[11]; const float* gk = p.in[12];
    float gqv[16], gkv[4];
#pragma unroll
    for (int e = 0; e < 16; ++e) gqv[e] = gq[16 * (lane & 3) + e];
#pragma unroll
    for (int e = 0; e < 4; ++e) gkv[e] = gk[4 * (lane & 15) + e];
    for (int m = gw; m < MT; m += NGW) {
        bf16_t* pr = PROJ + (size_t)m * NPROJ;
        {
            bf16_t* qp = pr + C_Q + 16 * lane;
            const u32x4 a = *(const u32x4*)qp, b = *(const u32x4*)(qp + 8);
            float v[16] = {bflo(a.x), bfhi(a.x), bflo(a.y), bfhi(a.y), bflo(a.z), bfhi(a.z), bflo(a.w), bfhi(a.w), bflo(b.x), bfhi(b.x), bflo(b.y), bfhi(b.y), bflo(b.z), bfhi(b.z), bflo(b.w), bfhi(b.w)};
            float s = 0.f;
#pragma unroll
            for (int e = 0; e < 16; ++e) s += v[e] * v[e];
            s += __shfl_xor(s, 1); s += __shfl_xor(s, 2);
            const float rs = 1.f / sqrtf(s * (1.f / 64) + EPS);
#pragma unroll
            for (int e = 0; e < 16; ++e) v[e] = v[e] * rs * gqv[e];
            u32x4 wa, wb; wa.x = pk2(v[0], v[1]); wa.y = pk2(v[2], v[3]); wa.z = pk2(v[4], v[5]); wa.w = pk2(v[6], v[7]);
            wb.x = pk2(v[8], v[9]); wb.y = pk2(v[10], v[11]); wb.z = pk2(v[12], v[13]); wb.w = pk2(v[14], v[15]);
            *(u32x4*)qp = wa; *(u32x4*)(qp + 8) = wb;
        }
        float* ko = (m < MP) ? p.out + O_KP + (size_t)m * 256 : p.out + O_KS + (size_t)(m - MP) * 256;
        float* vo = (m < MP) ? p.out + O_VP + (size_t)m * 256 : p.out + O_VS + (size_t)(m - MP) * 256;
        float* kio = (m < MP) ? p.out + O_KIP + (size_t)m * 64 : p.out + O_KIS + (size_t)(m - MP) * 64;
        {
            bf16_t* kp = pr + C_K + 4 * lane;
            const u32x2 a = *(const u32x2*)kp;
            float v[4] = {bflo(a.x), bfhi(a.x), bflo(a.y), bfhi(a.y)};
            float s = v[0] * v[0] + v[1] * v[1] + v[2] * v[2] + v[3] * v[3];
            s += __shfl_xor(s, 1); s += __shfl_xor(s, 2); s += __shfl_xor(s, 4); s += __shfl_xor(s, 8);
            const float rs = 1.f / sqrtf(s * (1.f / 64) + EPS);
#pragma unroll
            for (int e = 0; e < 4; ++e) v[e] = v[e] * rs * gkv[e];
            u32x2 w; w.x = pk2(v[0], v[1]); w.y = pk2(v[2], v[3]);
            *(u32x2*)kp = w;
            *(f32x4*)(ko + 4 * lane) = (f32x4){v[0], v[1], v[2], v[3]};
        }
        {
            const u32x2 a = *(const u32x2*)(pr + C_V + 4 * lane);
            *(f32x4*)(vo + 4 * lane) = (f32x4){bflo(a.x), bfhi(a.x), bflo(a.y), bfhi(a.y)};
        }
        kio[lane] = bf2f((unsigned)pr[C_KI + lane]);
    }
}

struct SeqInfo { int samp, bs, t, P, nvis, rowbase; };
__device__ __forceinline__ SeqInfo seq_of_row(int m) {
    SeqInfo s;
    if (m < MP) { s.samp = 0; s.bs = m / SEQ; s.t = m % SEQ; s.P = 0; s.nvis = (s.t / 64 + 1) * 64; s.rowbase = s.bs * SEQ; }
    else { s.samp = 1; s.bs = (m - MP) / DSEQ; s.t = (m - MP) % DSEQ; s.P = PAST; s.nvis = LS; s.rowbase = MP + s.bs * DSEQ; }
    return s;
}

constexpr int IX_CAP = 1024;
constexpr int IX_CTL = 131072, IX_BMP = 65536;
__device__ __forceinline__ unsigned ordkey(float f) { const unsigned u = __builtin_bit_cast(unsigned, f); return (u & 0x80000000u) ? ~u : (u | 0x80000000u); }

__device__ __forceinline__ void indexer_item(const Ctx& X, const Params& p, const bf16_t* PROJ, bf16_t* IDX, int item) {
    const int lane = X.lane, wid = X.wave, tid = X.tid;
    const int m0 = item * 8;
    const SeqInfo S = seq_of_row(m0);
    const int nvis = S.nvis, need = nvis < 256 ? nvis : 256, ntiles = nvis / 32;
    const bf16_t* CKI = (const bf16_t*)(p.ws + WS_CKI);
    LAS unsigned* hist = (LAS unsigned*)X.lds;
    LAS unsigned* ctl = (LAS unsigned*)(X.lds + IX_CTL);
    LAS u32x2* cand = (LAS u32x2*)X.lds;
    LAS unsigned* bmp = (LAS unsigned*)(X.lds + IX_BMP);
    __syncthreads();
#pragma unroll
    for (int r = 0; r < 8; ++r) *(LAS u32x4*)(X.lds + (r * 512 + tid) * 16) = (u32x4){0u, 0u, 0u, 0u};
    if (tid < 32) ctl[tid] = 0u;
    { LAS u32x4* bz = (LAS u32x4*)(X.lds + IX_BMP) + 2 * tid; bz[0] = (u32x4){0u, 0u, 0u, 0u}; bz[1] = (u32x4){0u, 0u, 0u, 0u}; }
    { u32x2 z = {0u, 0u}; *(u32x2*)(IDX + (size_t)(m0 + wid) * 256 + 4 * lane) = z; }
    const float bigf = __builtin_bit_cast(float, 0x7f000000u | ((unsigned)tid >> 20));
    const int rho = lane & 31, hi = lane >> 5, g = rho >> 3, qsel = (rho >> 2) & 1, jj = rho & 3, head = 4 * g + jj;
    bf16x8 af[4][4]; float w[4][16];
#pragma unroll
    for (int a = 0; a < 4; ++a) {
        const bf16_t* qp = PROJ + (size_t)(m0 + 2 * a + qsel) * NPROJ + C_QI + head * 64 + 8 * hi;
#pragma unroll
        for (int kk = 0; kk < 4; ++kk) af[a][kk] = *(const bf16x8*)(qp + 16 * kk);
        const bf16_t* wp = PROJ + (size_t)(m0 + 2 * a + hi) * NPROJ + C_WI;
        const u32x4 w0 = *(const u32x4*)wp, w1 = *(const u32x4*)(wp + 8);
        const float wv[16] = {bflo(w0.x), bfhi(w0.x), bflo(w0.y), bfhi(w0.y), bflo(w0.z), bfhi(w0.z), bflo(w0.w), bfhi(w0.w), bflo(w1.x), bfhi(w1.x), bflo(w1.y), bfhi(w1.y), bflo(w1.z), bfhi(w1.z), bflo(w1.w), bfhi(w1.w)};
#pragma unroll
        for (int i = 0; i < 16; ++i) w[a][i] = wv[i] * 0.25f;
    }
    asm volatile("s_waitcnt vmcnt(0)" ::: "memory");
    __syncthreads();
    {
        bf16x8 bnx[4];
        {
            const int s = wid * 32 + rho;
            const int sc_ = s < nvis ? s : nvis - 1;
            const bf16_t* kp;
            if (!S.samp) kp = PROJ + (size_t)(S.rowbase + sc_) * NPROJ + C_KI;
            else kp = (sc_ < PAST) ? CKI + (size_t)(S.bs * PAST + sc_) * 64 : PROJ + (size_t)(S.rowbase + sc_ - PAST) * NPROJ + C_KI;
#pragma unroll
            for (int kk = 0; kk < 4; ++kk) bnx[kk] = *(const bf16x8*)(kp + 16 * kk + 8 * hi);
        }
        for (int kt = wid; kt < ntiles; kt += 8) {
            const int s = kt * 32 + rho;
            bf16x8 bfr[4];
#pragma unroll
            for (int kk = 0; kk < 4; ++kk) bfr[kk] = bnx[kk];
            {
                const int s2 = s + 256, sc_ = s2 < nvis ? s2 : nvis - 1;
                const bf16_t* kp;
                if (!S.samp) kp = PROJ + (size_t)(S.rowbase + sc_) * NPROJ + C_KI;
                else kp = (sc_ < PAST) ? CKI + (size_t)(S.bs * PAST + sc_) * 64 : PROJ + (size_t)(S.rowbase + sc_ - PAST) * NPROJ + C_KI;
#pragma unroll
                for (int kk = 0; kk < 4; ++kk) bnx[kk] = *(const bf16x8*)(kp + 16 * kk + 8 * hi);
            }
            f32x16 accs[4];
            accs[0] = (f32x16){0, 0, 0, 0, 0, 0, 0, 0, 0, 0, 0, 0, 0, 0, 0, 0};
#pragma unroll
            for (int kk = 0; kk < 4; ++kk) accs[0] = __builtin_amdgcn_mfma_f32_32x32x16_bf16(af[0][kk], bfr[kk], accs[0], 0, 0, 0);
#pragma unroll
            for (int a = 0; a < 4; ++a) {
                if (a + 1 < 4) {
                    accs[a + 1] = (f32x16){0, 0, 0, 0, 0, 0, 0, 0, 0, 0, 0, 0, 0, 0, 0, 0};
#pragma unroll
                    for (int kk = 0; kk < 4; ++kk) accs[a + 1] = __builtin_amdgcn_mfma_f32_32x32x16_bf16(af[a + 1][kk], bfr[kk], accs[a + 1], 0, 0, 0);
                }
                const f32x16 acc = accs[a];
                float sp[4] = {0.f, 0.f, 0.f, 0.f};
#pragma unroll
                for (int i = 0; i < 16; ++i) sp[i & 3] = __builtin_fmaf(w[a][i], __builtin_amdgcn_fmed3f(acc[i], 0.f, bigf), sp[i & 3]);
                const float sc = (sp[0] + sp[1]) + (sp[2] + sp[3]);
                const unsigned key = ordkey(sc), bin = key >> 20;
                const int q = 2 * a + hi;
                atomicAdd((unsigned*)(hist + q * 2048 + (bin >> 1)), (bin & 1) ? 0x10000u : 1u);
            }
        }
    }
    asm volatile("s_waitcnt vmcnt(0) lgkmcnt(0)" ::: "memory");
    __syncthreads();
    {
            unsigned sv = 0;
            { const LAS unsigned* hq = hist + wid * 2048 + 32 * lane;
              for (int i = 0; i < 32; ++i) { const unsigned c = hq[i]; sv += (c & 0xffffu) + (c >> 16); } }
            unsigned sf = sv;
#pragma unroll
            for (int o = 1; o < 64; o <<= 1) { const unsigned t = __shfl_down(sf, o); if (lane + o < 64) sf += t; }
            sf -= sv;
            const unsigned long long bal = __ballot(sf < (unsigned)need && sf + sv >= (unsigned)need);
            const int Lc = bal ? __builtin_ctzll(bal) : 0;
            unsigned base = __shfl(sf, Lc);
            unsigned cn = hist[wid * 2048 + 32 * Lc + (lane >> 1)];
            cn = (lane & 1) ? (cn >> 16) : (cn & 0xffffu);
            unsigned sx = cn;
#pragma unroll
            for (int o = 1; o < 64; o <<= 1) { const unsigned t = __shfl_down(sx, o); if (lane + o < 64) sx += t; }
            base += sx - cn;
            if (base < (unsigned)need && base + cn >= (unsigned)need) { ctl[wid] = (unsigned)(64 * Lc + lane); ctl[8 + wid] = base; }
            LDS_WAIT();
            __syncthreads();
    }
    {
        unsigned thr[4];
#pragma unroll
        for (int a = 0; a < 4; ++a) thr[a] = ctl[2 * a + hi];
        bf16x8 bnx[4];
        {
            const int s = wid * 32 + rho;
            const int sc_ = s < nvis ? s : nvis - 1;
            const bf16_t* kp;
            if (!S.samp) kp = PROJ + (size_t)(S.rowbase + sc_) * NPROJ + C_KI;
            else kp = (sc_ < PAST) ? CKI + (size_t)(S.bs * PAST + sc_) * 64 : PROJ + (size_t)(S.rowbase + sc_ - PAST) * NPROJ + C_KI;
#pragma unroll
            for (int kk = 0; kk < 4; ++kk) bnx[kk] = *(const bf16x8*)(kp + 16 * kk + 8 * hi);
        }
        for (int kt = wid; kt < ntiles; kt += 8) {
            const int s = kt * 32 + rho;
            bf16x8 bfr[4];
#pragma unroll
            for (int kk = 0; kk < 4; ++kk) bfr[kk] = bnx[kk];
            {
                const int s2 = s + 256, sc_ = s2 < nvis ? s2 : nvis - 1;
                const bf16_t* kp;
                if (!S.samp) kp = PROJ + (size_t)(S.rowbase + sc_) * NPROJ + C_KI;
                else kp = (sc_ < PAST) ? CKI + (size_t)(S.bs * PAST + sc_) * 64 : PROJ + (size_t)(S.rowbase + sc_ - PAST) * NPROJ + C_KI;
#pragma unroll
                for (int kk = 0; kk < 4; ++kk) bnx[kk] = *(const bf16x8*)(kp + 16 * kk + 8 * hi);
            }
            f32x16 accs[4];
            accs[0] = (f32x16){0, 0, 0, 0, 0, 0, 0, 0, 0, 0, 0, 0, 0, 0, 0, 0};
#pragma unroll
            for (int kk = 0; kk < 4; ++kk) accs[0] = __builtin_amdgcn_mfma_f32_32x32x16_bf16(af[0][kk], bfr[kk], accs[0], 0, 0, 0);
#pragma unroll
            for (int a = 0; a < 4; ++a) {
                if (a + 1 < 4) {
                    accs[a + 1] = (f32x16){0, 0, 0, 0, 0, 0, 0, 0, 0, 0, 0, 0, 0, 0, 0, 0};
#pragma unroll
                    for (int kk = 0; kk < 4; ++kk) accs[a + 1] = __builtin_amdgcn_mfma_f32_32x32x16_bf16(af[a + 1][kk], bfr[kk], accs[a + 1], 0, 0, 0);
                }
                const f32x16 acc = accs[a];
                float sp[4] = {0.f, 0.f, 0.f, 0.f};
#pragma unroll
                for (int i = 0; i < 16; ++i) sp[i & 3] = __builtin_fmaf(w[a][i], __builtin_amdgcn_fmed3f(acc[i], 0.f, bigf), sp[i & 3]);
                const float sc = (sp[0] + sp[1]) + (sp[2] + sp[3]);
                const unsigned key = ordkey(sc), bin = key >> 20;
                const int q = 2 * a + hi;
                if (bin > thr[a]) {
                    atomicOr((unsigned*)(bmp + q * 512 + (s >> 5)), 1u << (s & 31));
                } else if (bin == thr[a]) {
                    const unsigned cp = atomicAdd((unsigned*)(ctl + 24 + q), 1u);
                    if (cp < (unsigned)IX_CAP) cand[q * IX_CAP + cp] = (u32x2){key, (unsigned)s};
                }
            }
        }
        asm volatile("s_waitcnt vmcnt(0) lgkmcnt(0)" ::: "memory");
        __syncthreads();
    }
    {
        const int q = wid;
        const unsigned cab = ctl[8 + q]; unsigned n1 = ctl[24 + q]; if (n1 > (unsigned)IX_CAP) n1 = IX_CAP;
        const int r = need - (int)cab;
        for (unsigned i = lane; i < n1; i += 64) {
            const u32x2 ci = cand[q * IX_CAP + i];
            int rank = 0;
            unsigned j = 0;
            for (; j + 8 <= n1; j += 8) {
                u32x2 cj[8];
#pragma unroll
                for (int u = 0; u < 8; ++u) cj[u] = cand[q * IX_CAP + j + u];
#pragma unroll
                for (int u = 0; u < 8; ++u) rank += (cj[u].x > ci.x || (cj[u].x == ci.x && cj[u].y < ci.y)) ? 1 : 0;
            }
            for (; j < n1; ++j) { const u32x2 cj = cand[q * IX_CAP + j]; rank += (cj.x > ci.x || (cj.x == ci.x && cj.y < ci.y)) ? 1 : 0; }
            if (rank < r) atomicOr((unsigned*)(bmp + q * 512 + (ci.y >> 5)), 1u << (ci.y & 31));
        }
        asm volatile("s_waitcnt vmcnt(0) lgkmcnt(0)" ::: "memory");
        __builtin_amdgcn_wave_barrier();
        unsigned wv[8]; unsigned cnt = 0;
#pragma unroll
        for (int i = 0; i < 8; ++i) { wv[i] = bmp[q * 512 + 8 * lane + i]; cnt += __builtin_popcount(wv[i]); }
        unsigned inc = cnt;
#pragma unroll
        for (int o = 1; o < 64; o <<= 1) { const unsigned t = __shfl_up(inc, o); if (lane >= o) inc += t; }
        unsigned pos = inc - cnt;
#pragma unroll
        for (int i = 0; i < 8; ++i) {
            unsigned wq = wv[i];
            while (wq) { const int bpos = __builtin_ctz(wq); wq &= wq - 1; if (pos < 256u) IDX[(size_t)(m0 + q) * 256 + pos] = (bf16_t)((8 * lane + i) * 32 + bpos); ++pos; }
        }
    }
    __syncthreads();
}

constexpr int AT_BIAS = 0, AT_LUT = 2048, AT_WAVE = 4096, AT_WSZ = 5120;
__device__ __forceinline__ void attn_setup(const Ctx& X, const Params& p) {
    LAS float* bl = (LAS float*)(X.lds + AT_BIAS);
    LAS unsigned char* lut = X.lds + AT_LUT;
    __syncthreads();
    if (X.tid < 512) bl[X.tid] = p.in[13][X.tid];
    if (X.tid < 128) { const int n = X.tid; lut[n] = (unsigned char)(n < 8 ? n : n < 12 ? 8 : n < 16 ? 9 : n < 23 ? 10 : n < 32 ? 11 : n < 46 ? 12 : n < 64 ? 13 : n < 91 ? 14 : 15); }
    __syncthreads();
}
struct AttnPre { u32x2 idxv; bf16x8 q0, q1; };
__device__ __forceinline__ AttnPre attn_prefetch(const Ctx& X, const bf16_t* PROJ, const bf16_t* IDX, int m) {
    AttnPre P; const int lane = X.lane, hn = lane & 15, lq = lane >> 4;
    P.idxv = *(const u32x2*)(IDX + (size_t)m * 256 + 4 * lane);
    const bf16_t* qp = PROJ + (size_t)m * NPROJ + C_Q + hn * 64 + 8 * lq; P.q0 = *(const bf16x8*)qp; P.q1 = *(const bf16x8*)(qp + 32);
    return P;
}
__device__ __forceinline__ const bf16_t* attn_row(const SeqInfo& S, const bf16_t* PROJ, const bf16_t* CX, int s, int coff) {
    if (!S.samp) return PROJ + (size_t)(S.rowbase + s) * NPROJ + coff;
    return (s < PAST) ? CX + (size_t)(S.bs * PAST + s) * 256 : PROJ + (size_t)(S.rowbase + s - PAST) * NPROJ + coff;
}
__device__ __forceinline__ void attn_query(const Ctx& X, const Params& p, bf16_t* PROJ, int m, const AttnPre& P) {
    const int lane = X.lane, hn = lane & 15, lq = lane >> 4;
    const SeqInfo S = seq_of_row(m);
    const int qpos = S.P + S.t, nvalid = S.nvis < 256 ? S.nvis : 256;
    const LAS float* bl = (const LAS float*)(X.lds + AT_BIAS);
    const LAS unsigned char* lut = X.lds + AT_LUT;
    LAS unsigned char* wl = X.lds + AT_WAVE + X.wave * AT_WSZ;
    LAS bf16_t* idl = (LAS bf16_t*)(wl + 4352);
    const bf16_t* CK = (const bf16_t*)(p.ws + WS_CK); const bf16_t* CV = (const bf16_t*)(p.ws + WS_CV);
    *(LAS u32x2*)(idl + 4 * lane) = P.idxv;
    const bf16x8 zero8 = {0, 0, 0, 0, 0, 0, 0, 0};
    const int myn = hn >> 2;
    bf16x8 qm[4][2];
#pragma unroll
    for (int n = 0; n < 4; ++n) { qm[n][0] = (myn == n) ? P.q0 : zero8; qm[n][1] = (myn == n) ? P.q1 : zero8; }
    LDS_WAIT();
    float lg[16][4];
    float mx = -INFINITY;
    bf16x8 kb[2][8];
#pragma unroll
    for (int T = 0; T < 2; ++T) {
        const bf16_t* kp = attn_row(S, PROJ, CK, (int)idl[16 * T + hn], C_K) + 8 * lq;
#pragma unroll
        for (int f = 0; f < 8; ++f) kb[T][f] = *(const bf16x8*)(kp + (f >> 1) * 64 + 32 * (f & 1));
    }
#pragma unroll
    for (int T = 0; T < 16; ++T) {
        f32x4 acc = {0.f, 0.f, 0.f, 0.f};
#pragma unroll
        for (int f = 0; f < 8; ++f) acc = __builtin_amdgcn_mfma_f32_16x16x32_bf16(kb[T & 1][f], qm[f >> 1][f & 1], acc, 0, 0, 0);
        if (T + 2 < 16) {
            const bf16_t* kp = attn_row(S, PROJ, CK, (int)idl[16 * (T + 2) + hn], C_K) + 8 * lq;
#pragma unroll
            for (int f = 0; f < 8; ++f) kb[T & 1][f] = *(const bf16x8*)(kp + (f >> 1) * 64 + 32 * (f & 1));
        }
#pragma unroll
        for (int i = 0; i < 4; ++i) {
            const int j = 16 * T + 4 * lq + i;
            const int si = (int)idl[j];
            const int rel = si - qpos; int n = rel < 0 ? -rel : rel; n = n > 127 ? 127 : n;
            const int bucket = (rel > 0 ? 16 : 0) + (int)lut[n];
            float v = acc[i] * 0.125f + bl[bucket * 16 + hn];
            v = (j < nvalid) ? v : -INFINITY;
            lg[T][i] = v; mx = fmaxf(mx, v);
        }
    }
    const int r = lane & 31, half = lane >> 5;
    u32x4 vv[4][4];
    {
        const bf16_t* vp = attn_row(S, PROJ, CV, (int)idl[r], C_V) + 32 * half;
#pragma unroll
        for (int n = 0; n < 4; ++n)
#pragma unroll
            for (int cc = 0; cc < 4; ++cc) vv[n][cc] = *(const u32x4*)(vp + n * 64 + 8 * cc);
    }
    mx = fmaxf(mx, __shfl_xor(mx, 16)); mx = fmaxf(mx, __shfl_xor(mx, 32));
    float sum = 0.f;
#pragma unroll
    for (int T = 0; T < 16; ++T)
#pragma unroll
        for (int i = 0; i < 4; ++i) { const float e = __expf(lg[T][i] - mx); lg[T][i] = e; sum += e; }
    sum += __shfl_xor(sum, 16); sum += __shfl_xor(sum, 32);
    const float inv = 1.f / sum;
    bf16x8 pf[8];
#pragma unroll
    for (int u = 0; u < 8; ++u) {
        u32x4 pw; pw.x = pk2(lg[2 * u][0] * inv, lg[2 * u][1] * inv); pw.y = pk2(lg[2 * u][2] * inv, lg[2 * u][3] * inv);
        pw.z = pk2(lg[2 * u + 1][0] * inv, lg[2 * u + 1][1] * inv); pw.w = pk2(lg[2 * u + 1][2] * inv, lg[2 * u + 1][3] * inv);
        pf[u] = __builtin_bit_cast(bf16x8, pw);
    }
    f32x4 O[4];
#pragma unroll
    for (int db = 0; db < 4; ++db) O[db] = (f32x4){0.f, 0.f, 0.f, 0.f};
#pragma unroll
    for (int u = 0; u < 8; ++u) {
        u32x4 vn[4][4];
        if (u + 1 < 8) {
            const bf16_t* vp = attn_row(S, PROJ, CV, (int)idl[32 * (u + 1) + r], C_V) + 32 * half;
#pragma unroll
            for (int n = 0; n < 4; ++n)
#pragma unroll
                for (int cc = 0; cc < 4; ++cc) vn[n][cc] = *(const u32x4*)(vp + n * 64 + 8 * cc);
        }
#pragma unroll
        for (int n = 0; n < 4; ++n) {
            LDS_WAIT(); __builtin_amdgcn_wave_barrier();
#pragma unroll
            for (int cc = 0; cc < 4; ++cc) *(LAS u32x4*)(wl + r * 136 + 16 * (4 * half + cc)) = vv[n][cc];
            LDS_WAIT(); __builtin_amdgcn_wave_barrier();
            const bf16x8 pa = (myn == n) ? pf[u] : zero8;
#pragma unroll
            for (int db = 0; db < 4; ++db) {
                const LAS unsigned char* tp = wl + (4 * lq + ((lane >> 2) & 3)) * 136 + 2 * (16 * db + 4 * (lane & 3));
                const v4i16_t t0 = __builtin_amdgcn_ds_read_tr16_b64_v4i16((LAS v4i16_t*)tp);
                const v4i16_t t1 = __builtin_amdgcn_ds_read_tr16_b64_v4i16((LAS v4i16_t*)(tp + 16 * 136));
                bf16x8 vb; vb[0] = t0[0]; vb[1] = t0[1]; vb[2] = t0[2]; vb[3] = t0[3]; vb[4] = t1[0]; vb[5] = t1[1]; vb[6] = t1[2]; vb[7] = t1[3];
                O[db] = __builtin_amdgcn_mfma_f32_16x16x32_bf16(pa, vb, O[db], 0, 0, 0);
            }
        }
        if (u + 1 < 8) {
#pragma unroll
            for (int n = 0; n < 4; ++n)
#pragma unroll
                for (int cc = 0; cc < 4; ++cc) vv[n][cc] = vn[n][cc];
        }
    }
    LDS_WAIT(); __builtin_amdgcn_wave_barrier();
    bf16_t* op = PROJ + (size_t)m * NPROJ + C_Q;
#pragma unroll
    for (int db = 0; db < 4; ++db)
#pragma unroll
        for (int i = 0; i < 4; ++i) op[(4 * lq + i) * 64 + 16 * db + hn] = (bf16_t)f2bf(O[db][i]);
}

constexpr int HG_NP = 4096, HG_NS = 64;
struct HgItem { int samp, sh, c, h, row0, nvalid; };
__device__ __forceinline__ HgItem hg_item(int id) {
    HgItem I;
    if (id < HG_NP) { I.samp = 0; I.sh = id >> 8; I.c = id & 255; I.h = I.sh & 7; I.row0 = (I.sh >> 3) * SEQ + I.c * 64; I.nvalid = 64; }
    else { const int k = id - HG_NP; I.samp = 1; I.sh = k; I.c = 0; I.h = k & 7; I.row0 = MP + (k >> 3) * DSEQ; I.nvalid = 32; }
    return I;
}
__device__ __forceinline__ bf16_t* hg_state_ptr(const Params& p, int id) {
    return (id < HG_NP) ? (bf16_t*)(p.ws + WS_H) + (size_t)id * 16384 : (bf16_t*)(p.ws + WS_SST) + (size_t)(id - HG_NP) * 16384;
}
constexpr int HP = 144;

__device__ __forceinline__ void hg_gates(const Ctx& X, const Params& p, const bf16_t* PROJ, const HgItem& I, LAS float* part, float (&b)[16], float (&kk)[16], float& bend, float (&pref)[4]) {
    const int col = X.tid & 127, tq = X.tid >> 7;
    const float r0 = p.in[14][I.h * 128 + col], r1 = p.in[14][1024 + I.h * 128 + col];
    const float lb = sigmoidf_(r0 - r1);
    float run = 0.f;
#pragma unroll
    for (int j = 0; j < 16; ++j) {
        const int t = 16 * tq + j, tc = t < I.nvalid ? t : I.nvalid - 1;
        const float rf = bf2f((unsigned)PROJ[(size_t)(I.row0 + tc) * NPROJ + C_RF + I.h * 128 + col]);
        const float f = lb + (1.f - lb) * sigmoidf_(rf);
        const float g = (t < I.nvalid) ? __logf(f) : 0.f, k1 = (t < I.nvalid) ? 1.f - f : 0.f;
        run += g; b[j] = run; kk[j] = k1;
    }
    part[tq * 128 + col] = run;
    __syncthreads();
    float off = 0.f, tot = 0.f;
#pragma unroll
    for (int q = 0; q < 4; ++q) { const float v = part[q * 128 + col]; pref[q] = tot; if (q < tq) off += v; tot += v; }
#pragma unroll
    for (int j = 0; j < 16; ++j) b[j] += off;
    bend = tot;
}
__device__ __forceinline__ void hg_store16(LAS unsigned char* base, int row, int tq, const float (&v)[16]) {
    u32x4 a, c; a.x = pk2(v[0], v[1]); a.y = pk2(v[2], v[3]); a.z = pk2(v[4], v[5]); a.w = pk2(v[6], v[7]);
    c.x = pk2(v[8], v[9]); c.y = pk2(v[10], v[11]); c.z = pk2(v[12], v[13]); c.w = pk2(v[14], v[15]);
    *(LAS u32x4*)(base + row * HP + 32 * tq) = a; *(LAS u32x4*)(base + row * HP + 32 * tq + 16) = c;
}
__device__ __forceinline__ void hg_load_vt(const Ctx& X, const bf16_t* PROJ, const HgItem& I, LAS unsigned char* VT) {
    const int col = X.tid & 127, tq = X.tid >> 7;
    float v[16];
#pragma unroll
    for (int j = 0; j < 16; ++j) { const int t = 16 * tq + j, tc = t < I.nvalid ? t : I.nvalid - 1; const float x = bf2f((unsigned)PROJ[(size_t)(I.row0 + tc) * NPROJ + C_RI + I.h * 128 + col]); v[j] = (t < I.nvalid) ? x : 0.f; }
    hg_store16(VT, col, tq, v);
}

__device__ __forceinline__ void hg1_item(const Ctx& X, const Params& p, const bf16_t* PROJ, int id) {
    const HgItem I = hg_item(id);
    LAS unsigned char* KT = X.lds; LAS unsigned char* VT = X.lds + 128 * HP; LAS float* part = (LAS float*)(X.lds + 2 * 128 * HP);
    const int col = X.tid & 127, tq = X.tid >> 7;
    unsigned riv[16];
#pragma unroll
    for (int j = 0; j < 16; ++j) { const int t = 16 * tq + j, tc = t < I.nvalid ? t : I.nvalid - 1; riv[j] = (unsigned)PROJ[(size_t)(I.row0 + tc) * NPROJ + C_RI + I.h * 128 + col]; }
    __syncthreads();
    float b[16], kk[16], bend, pref[4];
    hg_gates(X, p, PROJ, I, part, b, kk, bend, pref);
#pragma unroll
    for (int j = 0; j < 16; ++j) kk[j] = kk[j] * __expf(bend - b[j]);
    hg_store16(KT, col, tq, kk);
    {
        float vv[16];
#pragma unroll
        for (int j = 0; j < 16; ++j) vv[j] = (16 * tq + j < I.nvalid) ? bf2f(riv[j]) : 0.f;
        hg_store16(VT, col, tq, vv);
    }
    if (tq == 0) ((float*)(p.ws + WS_HD))[(size_t)id * 128 + col] = __expf(bend);
    LDS_WAIT();
    __syncthreads();
    bf16_t* dst = (id < HG_NP) ? hg_state_ptr(p, id) : (bf16_t*)(p.ws + WS_SDL) + (size_t)(id - HG_NP) * 16384;
    const int lane = X.lane, l32 = lane & 31, hi = lane >> 5;
    const int ti = X.wave >> 1;
#pragma unroll
    for (int tt = 0; tt < 2; ++tt) {
        const int tj = 2 * (X.wave & 1) + tt;
        f32x16 acc = {0, 0, 0, 0, 0, 0, 0, 0, 0, 0, 0, 0, 0, 0, 0, 0};
#pragma unroll
        for (int s4 = 0; s4 < 4; ++s4) {
            const bf16x8 a = *(const LAS bf16x8*)(KT + (32 * ti + l32) * HP + 32 * s4 + 16 * hi);
            const bf16x8 bb = *(const LAS bf16x8*)(VT + (32 * tj + l32) * HP + 32 * s4 + 16 * hi);
            acc = __builtin_amdgcn_mfma_f32_32x32x16_bf16(a, bb, acc, 0, 0, 0);
        }
#pragma unroll
        for (int g = 0; g < 4; ++g) {
            u32x2 w; w.x = pk2(acc[4 * g], acc[4 * g + 1]); w.y = pk2(acc[4 * g + 2], acc[4 * g + 3]);
            *(u32x2*)(dst + (size_t)(32 * tj + l32) * 128 + 32 * ti + 8 * g + 4 * hi) = w;
        }
    }
}

__device__ __forceinline__ void hg2_prompt(const Ctx& X, const Params& p, int item) {
    const int e = item * 1024 + 2 * X.tid;
    const int sh = e >> 14, v = (e >> 7) & 127, k = e & 127;
    unsigned* st = (unsigned*)((bf16_t*)(p.ws + WS_H) + (size_t)sh * 256 * 16384 + (size_t)v * 128 + k);
    const float* hd = (const float*)(p.ws + WS_HD) + (size_t)sh * 256 * 128 + k;
    float s0 = 0.f, s1 = 0.f;
    for (int c0 = 0; c0 < 256; c0 += 32) {
        unsigned d[32]; float dx[32], dy[32];
#pragma unroll
        for (int u = 0; u < 32; ++u) { d[u] = st[(size_t)(c0 + u) * 8192]; dx[u] = hd[(c0 + u) * 128]; dy[u] = hd[(c0 + u) * 128 + 1]; }
#pragma unroll
        for (int u = 0; u < 32; ++u) {
            st[(size_t)(c0 + u) * 8192] = pk2(s0, s1);
            s0 = dx[u] * s0 + bflo(d[u]); s1 = dy[u] * s1 + bfhi(d[u]);
        }
    }
    float* o = p.out + O_HP + (size_t)sh * 16384;
    o[k * 128 + v] = s0; o[(k + 1) * 128 + v] = s1;
}
__device__ __forceinline__ void hg2_sample(const Ctx& X, const Params& p, int item) {
    const int e = item * 1024 + 2 * X.tid;
    const int sh = e >> 14, v = (e >> 7) & 127, k = e & 127;
    const float* s0p = p.in[5] + (size_t)sh * 16384;
    const float a0 = s0p[k * 128 + v], a1 = s0p[(k + 1) * 128 + v];
    const size_t off = (size_t)sh * 16384 + (size_t)v * 128 + k;
    *(unsigned*)((bf16_t*)(p.ws + WS_SST) + off) = pk2(a0, a1);
    const unsigned d = *(const unsigned*)((const bf16_t*)(p.ws + WS_SDL) + off);
    const float* hd = (const float*)(p.ws + WS_HD) + (size_t)(HG_NP + sh) * 128 + k;
    float* o = p.out + O_HS + (size_t)sh * 16384;
    o[k * 128 + v] = hd[0] * a0 + bflo(d); o[(k + 1) * 128 + v] = hd[1] * a1 + bfhi(d);
}

constexpr int H3_AQI = 0, H3_AQD = 64 * 272, H3_BK = 2 * 64 * 272, H3_VT = H3_BK + 160 * 272, H3_PL = H3_VT + 128 * HP, H3_MISC = H3_PL + 64 * HP;
__device__ __forceinline__ void hg3_item(const Ctx& X, const Params& p, bf16_t* PROJ, int id) {
    const HgItem I = hg_item(id);
    LAS unsigned char* L = X.lds;
    LAS float* part = (LAS float*)(L + H3_MISC); LAS float* mu = part + 512; LAS float* ssq = mu + 512;
    const int tid = X.tid, col = tid & 127, tq = tid >> 7, lane = X.lane;
    const int l32 = lane & 31, hi = lane >> 5, l16 = lane & 15, lq = lane >> 4;
    const int ti = X.wave >> 2, tj = X.wave & 3;
    unsigned rqv[16], riv[16], rgv[16]; bf16x8 sfr[8];
    {
        const bf16_t* pc0 = PROJ + I.h * 128;
#pragma unroll
        for (int j = 0; j < 16; ++j) {
            const int t = 16 * tq + j, tc = t < I.nvalid ? t : I.nvalid - 1;
            const bf16_t* pr = pc0 + (size_t)(I.row0 + tc) * NPROJ + col;
            rqv[j] = (unsigned)pr[C_RQ]; riv[j] = (unsigned)pr[C_RI];
        }
#pragma unroll
        for (int r = 0; r < 16; ++r) {
            const int t = 32 * ti + 8 * (r >> 2) + 4 * hi + (r & 3), tc = t < I.nvalid ? t : I.nvalid - 1;
            rgv[r] = (unsigned)pc0[(size_t)(I.row0 + tc) * NPROJ + C_RG + 32 * tj + l32];
        }
        const bf16_t* sp = hg_state_ptr(p, id) + (size_t)(32 * tj + l32) * 128 + 8 * hi;
#pragma unroll
        for (int ks = 0; ks < 8; ++ks) sfr[ks] = *(const bf16x8*)(sp + 16 * ks);
    }
    __syncthreads();
    float b[16], kk[16], bend, pref[4];
    hg_gates(X, p, PROJ, I, part, b, kk, bend, pref);
    mu[tq * 128 + col] = b[7];
    for (int i = tid; i < 64 * HP / 16; i += 512) *(LAS u32x4*)(L + H3_PL + 16 * i) = (u32x4){0u, 0u, 0u, 0u};
    LDS_WAIT();
    __syncthreads();
    {
        float mus[4];
#pragma unroll
        for (int q = 0; q < 4; ++q) mus[q] = mu[q * 128 + col];
#pragma unroll
        for (int j = 0; j < 16; ++j) {
            const int t = 16 * tq + j;
            float qq = siluf_(bf2f(rqv[j]));
            qq = (t < I.nvalid) ? qq : 0.f;
            *(LAS bf16_t*)(L + H3_AQI + t * 272 + 2 * col) = (bf16_t)f2bf(qq * __expf(b[j]));
            *(LAS bf16_t*)(L + H3_AQD + t * 272 + 2 * col) = (bf16_t)f2bf(qq * __expf(b[j] - mus[tq]));
#pragma unroll
            for (int i = 0; i < 4; ++i) {
                if (i >= tq) {
                    const int rbase = 8 * i * (i + 1);
                    *(LAS bf16_t*)(L + H3_BK + (rbase + t) * 272 + 2 * col) = (bf16_t)f2bf(kk[j] * __expf(mus[i] - b[j]));
                }
            }
        }
        {
            float vv[16];
#pragma unroll
            for (int j = 0; j < 16; ++j) vv[j] = (16 * tq + j < I.nvalid) ? bf2f(riv[j]) : 0.f;
            hg_store16(L + H3_VT, col, tq, vv);
        }
    }
    LDS_WAIT();
    __syncthreads();
    f32x16 acc = {0, 0, 0, 0, 0, 0, 0, 0, 0, 0, 0, 0, 0, 0, 0, 0};
    {
#pragma unroll
        for (int ks = 0; ks < 8; ++ks) {
            const bf16x8 a = *(const LAS bf16x8*)(L + H3_AQI + (32 * ti + l32) * 272 + 32 * ks + 16 * hi);
            const bf16x8 bb = sfr[ks];
            acc = __builtin_amdgcn_mfma_f32_32x32x16_bf16(a, bb, acc, 0, 0, 0);
        }
    }
    for (int tile = X.wave; tile < 10; tile += 8) {
        int i = 0, js = tile; while (js > i) { js -= i + 1; ++i; }
        const int rbase = 8 * i * (i + 1);
        f32x4 pc = {0.f, 0.f, 0.f, 0.f};
#pragma unroll
        for (int ks = 0; ks < 4; ++ks) {
            const bf16x8 a = *(const LAS bf16x8*)(L + H3_AQD + (16 * i + l16) * 272 + 64 * ks + 16 * lq);
            const bf16x8 bb = *(const LAS bf16x8*)(L + H3_BK + (rbase + 16 * js + l16) * 272 + 64 * ks + 16 * lq);
            pc = __builtin_amdgcn_mfma_f32_16x16x32_bf16(a, bb, pc, 0, 0, 0);
        }
#pragma unroll
        for (int r = 0; r < 4; ++r) {
            const int tl = 4 * lq + r; float v = pc[r];
            if (js == i && l16 > tl) v = 0.f;
            *(LAS bf16_t*)(L + H3_PL + (16 * i + tl) * HP + 2 * (16 * js + l16)) = (bf16_t)f2bf(v);
        }
    }
    LDS_WAIT();
    __syncthreads();
#pragma unroll
    for (int ss = 0; ss < 4; ++ss) {
        const bf16x8 a = *(const LAS bf16x8*)(L + H3_PL + (32 * ti + l32) * HP + 32 * ss + 16 * hi);
        const bf16x8 bb = *(const LAS bf16x8*)(L + H3_VT + (32 * tj + l32) * HP + 32 * ss + 16 * hi);
        acc = __builtin_amdgcn_mfma_f32_32x32x16_bf16(a, bb, acc, 0, 0, 0);
    }
#pragma unroll
    for (int r = 0; r < 16; ++r) {
        float s = acc[r] * acc[r];
        s += __shfl_xor(s, 1); s += __shfl_xor(s, 2); s += __shfl_xor(s, 4); s += __shfl_xor(s, 8); s += __shfl_xor(s, 16);
        if (l32 == 0) ssq[(32 * ti + 8 * (r >> 2) + 4 * hi + (r & 3)) * 4 + tj] = s;
    }
    LDS_WAIT();
    __syncthreads();
    const int v = 32 * tj + l32;
    const float gr = p.in[15][v];
#pragma unroll
    for (int r = 0; r < 16; ++r) {
        const int t = 32 * ti + 8 * (r >> 2) + 4 * hi + (r & 3), tc = t < I.nvalid ? t : I.nvalid - 1;
        const f32x4 q4 = *(const LAS f32x4*)(ssq + t * 4);
        const float rs = 1.f / sqrtf(((q4.x + q4.y) + (q4.z + q4.w)) * (1.f / 128) + EPS);
        bf16_t* pr = PROJ + (size_t)(I.row0 + tc) * NPROJ;
        const float rg = bf2f(rgv[r]);
        if (t < I.nvalid) pr[C_RQ + I.h * 128 + v] = (bf16_t)f2bf(acc[r] * rs * gr * siluf_(rg));
    }
}


template <int MODE> __device__ __forceinline__ void skinny_gemm(const Ctx& X, const bf16_t* A, int lda, const bf16_t* Bt, int K, bf16_t* O, float* Y, const float* R1, float alpha) {
    const int lane = X.lane, r16 = lane & 15, q = lane >> 4;
    for (int item = X.bid; item < 256; item += X.G) {
        const int cg = item >> 1, half = item & 1;
        const bf16_t* ap = A + (size_t)(128 * half + 16 * X.wave + r16) * lda + 8 * q;
        const bf16_t* bp = Bt + (size_t)(16 * cg + r16) * K + 8 * q;
        f32x4 acc0 = {0.f, 0.f, 0.f, 0.f}, acc1 = {0.f, 0.f, 0.f, 0.f};
        for (int k0 = 0; k0 < K; k0 += 256) {
            bf16x8 af[8], bf[8];
#pragma unroll
            for (int u = 0; u < 8; ++u) { af[u] = *(const bf16x8*)(ap + k0 + 32 * u); bf[u] = *(const bf16x8*)(bp + k0 + 32 * u); }
#pragma unroll
            for (int u = 0; u < 8; u += 2) { acc0 = __builtin_amdgcn_mfma_f32_16x16x32_bf16(af[u], bf[u], acc0, 0, 0, 0); acc1 = __builtin_amdgcn_mfma_f32_16x16x32_bf16(af[u + 1], bf[u + 1], acc1, 0, 0, 0); }
        }
        const int col = 16 * cg + r16;
#pragma unroll
        for (int i = 0; i < 4; ++i) {
            const int rl = 128 * half + 16 * X.wave + 4 * q + i;
            const float v = acc0[i] + acc1[i];
            if constexpr (MODE == pg8::EPI_RESID) {
                Y[(size_t)(MP + rl) * DM + col] = R1[(size_t)rl * DM + col] + alpha * v;
            } else {
                bf16_t* op = O + (size_t)(MP + rl) * NPROJ + C_GA + col;
                const float g = bf2f((unsigned)*op);
                if constexpr (MODE == pg8::EPI_MERGE1) *op = (bf16_t)f2bf(g * v);
                else { const float gb = bf2f((unsigned)op[C_GB - C_GA]); *op = (bf16_t)f2bf(g + gb * v); }
            }
        }
    }
}

#ifndef TIMING
#define TIMING 0
#define TIME_A0 0
#define TIME_A1 0
#define TIME_B0 0
#define TIME_B1 0
#endif
#ifndef DUP_PHASE
#define DUP_PHASE -1
#endif
__global__ void __launch_bounds__(512, 2) mega(Params p) {
    __builtin_assume(__builtin_amdgcn_workitem_id_y() == 0); __builtin_assume(__builtin_amdgcn_workitem_id_z() == 0);
    extern __shared__ __attribute__((aligned(16))) unsigned char smem[];
    Ctx X; X.lds = (LAS unsigned char*)smem; X.tid = threadIdx.x; X.lane = X.tid & 63; X.wave = __builtin_amdgcn_readfirstlane(X.tid >> 6); X.G = gridDim.x; X.bid = blockIdx.x;
    cg::grid_group grid = cg::this_grid();
    unsigned char* ws = p.ws;
    bf16_t* WA = (bf16_t*)(ws + WS_A); bf16_t* WB = (bf16_t*)(ws + WS_B); bf16_t* WATT = (bf16_t*)(ws + WS_WATT); bf16_t* WREC = (bf16_t*)(ws + WS_WREC); bf16_t* WOUT = (bf16_t*)(ws + WS_WOUT);
    bf16_t* H = (bf16_t*)(ws + WS_H); bf16_t* BIG = (bf16_t*)(ws + WS_BIG); bf16_t* IDX = (bf16_t*)(ws + WS_IDX);
    float* Y = p.out + O_Y;
    const int lo = p.ph_lo, hi = p.ph_hi;
#define IN(k) (lo <= (k) && (k) < hi)
#if TIMING
#define SEAM(k) do { if (IN(k) && IN((k) + 1)) grid.sync(); if (X.bid == 0 && X.tid == 0) ((volatile unsigned long long*)ws)[(k) + 1] = __builtin_amdgcn_s_memrealtime(); } while (0)
#else
#define SEAM(k) do { if (IN(k) && IN((k) + 1)) grid.sync(); } while (0)
#endif
#if TIMING
    if (X.bid == 0 && X.tid == 0) ((volatile unsigned long long*)ws)[0] = __builtin_amdgcn_s_memrealtime();
#endif
    if (IN(0)) {
        convert_weight<1>(X, p.in[7], DM, NFF, WA);
        convert_weight<0>(X, p.in[8], DFF, DM, WB);
        convert_weight<0>(X, p.in[16], 1024, DM, WATT);
        convert_weight<0>(X, p.in[17], 1024, DM, WREC);
        convert_weight<0>(X, p.in[18], DM, DM, WOUT);
        rmsnorm_rows(X, p.in[0], p.in[1], p.in[6], H);
    }
    SEAM(0);
    if (IN(1)) for (int rep = 0; rep < (DUP_PHASE == 1 ? 2 : 1); ++rep) {
        pg8::Gemm g{H, WA, MT, NFF, DM, DM}; pg8::StaticOrder S; S.init(MT, NFF, X.G, X.bid);
        pg8::Epi<pg8::EPI_SWIGLU> E{BIG, nullptr, nullptr, nullptr, 0.f};
        pg8::gemm_phase<pg8::Epi<pg8::EPI_SWIGLU>, pg8::StaticOrder, true, true>(X.lds, g, S, E);
    }
    SEAM(1);
    if (IN(2)) {
        convert_weight<2>(X, p.in[10], DM, 10832, WA);
        for (size_t i = ((size_t)X.bid * 512 + X.tid) * 8; i < (size_t)(NPROJ - 10832) * DM; i += (size_t)X.G * 512 * 8) *(u32x4*)(WA + (size_t)10832 * DM + i) = (u32x4){0u, 0u, 0u, 0u};
        __syncthreads();
        pg8::Gemm g{BIG, WB, MP, DM, DFF, DFF}; pg8::StaticOrder S; S.init(MP, DM, X.G, X.bid);
        pg8::Epi<pg8::EPI_RESID> E{nullptr, Y, p.in[0], p.in[1], 0.5f};
        pg8::gemm_phase<pg8::Epi<pg8::EPI_RESID>, pg8::StaticOrder, true, true>(X.lds, g, S, E);
        skinny_gemm<pg8::EPI_RESID>(X, BIG + (size_t)MP * DFF, DFF, WB, DFF, nullptr, Y, p.in[1], 0.5f);
    }
    SEAM(2);
    if (IN(3)) {
        rmsnorm_rows(X, Y, Y + (size_t)MP * DM, p.in[9], H);
        convert_weight<0>(X, p.in[21], DFF, DM, WB);
        convert_flat(X, p.in[2], (bf16_t*)(ws + WS_CK), (size_t)8 * PAST * 256);
        convert_flat(X, p.in[3], (bf16_t*)(ws + WS_CV), (size_t)8 * PAST * 256);
        convert_flat(X, p.in[4], (bf16_t*)(ws + WS_CKI), (size_t)8 * PAST * 64);
    }
    SEAM(3);
    if (IN(4)) for (int rep = 0; rep < (DUP_PHASE == 4 ? 2 : 1); ++rep) {
        pg8::Gemm g{H, WA, MT, NPROJ, DM, DM}; pg8::StaticOrder S; S.init(MT, NPROJ, X.G, X.bid);
        pg8::Epi<pg8::EPI_PROJ> E{BIG, nullptr, nullptr, nullptr, 0.f};
        pg8::gemm_phase<pg8::Epi<pg8::EPI_PROJ>, pg8::StaticOrder, true, true>(X.lds, g, S, E);
    }
    SEAM(4);
    if (IN(5)) {
        postproj_rows(X, p, BIG);
        convert_weight<1>(X, p.in[20], DM, NFF, WA);
    }
    SEAM(5);
    if (IN(6)) for (int rep = 0; rep < (DUP_PHASE == 6 ? 2 : 1); ++rep) {
        for (int it = X.bid; it < HG_NP + HG_NS; it += X.G) hg1_item(X, p, BIG, it);
        for (int j = 0; j * X.G < MT / 8; ++j) { const int it = j * X.G + ((j & 1) ? X.G - 1 - X.bid : X.bid); if (it < MT / 8) indexer_item(X, p, BIG, IDX, it); }
    }
    SEAM(6);
    if (IN(7)) {
        for (int it = X.bid; it < 256; it += X.G) hg2_prompt(X, p, it);
        for (int it = X.bid; it < 1024; it += X.G) hg2_sample(X, p, it);
        attn_setup(X, p);
        {
            const int vcu = (X.G % 8 == 0) ? (X.bid & 7) * (X.G / 8) + (X.bid >> 3) : X.bid;
            const int wg = vcu * 8 + X.wave, nwg = X.G * 8, per = MP / nwg;
            const int nq = per + ((wg < MT - per * nwg) ? 1 : 0);
            auto row_of = [&](int j) { return j < per ? wg * per + j : per * nwg + wg; };
            AttnPre P = attn_prefetch(X, BIG, IDX, row_of(0));
            for (int j = 0; j < nq; ++j) {
                const int m = row_of(j);
                const AttnPre Pn = attn_prefetch(X, BIG, IDX, (j + 1 < nq) ? row_of(j + 1) : m);
                attn_query(X, p, BIG, m, P);
                P = Pn;
            }
        }
    }
    SEAM(7);
    if (IN(8)) {
        for (int it = X.bid; it < HG_NP + HG_NS; it += X.G) hg3_item(X, p, BIG, it);
        __syncthreads();
    }
    SEAM(8);
    if (IN(9)) {
        pg8::Gemm g{BIG + C_Q, WATT, MP, DM, 1024, NPROJ}; pg8::StaticOrder S; S.init(MP, DM, X.G, X.bid);
        pg8::Epi<pg8::EPI_MERGE1> E{BIG, nullptr, nullptr, nullptr, 0.f};
        pg8::gemm_phase<pg8::Epi<pg8::EPI_MERGE1>, pg8::StaticOrder, true, true>(X.lds, g, S, E);
        skinny_gemm<pg8::EPI_MERGE1>(X, BIG + (size_t)MP * NPROJ + C_Q, NPROJ, WATT, 1024, BIG, nullptr, nullptr, 0.f);
    }
    SEAM(9);
    if (IN(10)) {
        pg8::Gemm g{BIG + C_RQ, WREC, MP, DM, 1024, NPROJ}; pg8::StaticOrder S; S.init(MP, DM, X.G, X.bid);
        pg8::Epi<pg8::EPI_MERGE2> E{BIG, nullptr, nullptr, nullptr, 0.f};
        pg8::gemm_phase<pg8::Epi<pg8::EPI_MERGE2>, pg8::StaticOrder, true, true>(X.lds, g, S, E);
        skinny_gemm<pg8::EPI_MERGE2>(X, BIG + (size_t)MP * NPROJ + C_RQ, NPROJ, WREC, 1024, BIG, nullptr, nullptr, 0.f);
    }
    SEAM(10);
    if (IN(11)) {
        pg8::Gemm g{BIG + C_GA, WOUT, MP, DM, DM, NPROJ}; pg8::StaticOrder S; S.init(MP, DM, X.G, X.bid);
        pg8::Epi<pg8::EPI_RESID> E{nullptr, Y, Y, Y + (size_t)MP * DM, 1.f};
        pg8::gemm_phase<pg8::Epi<pg8::EPI_RESID>, pg8::StaticOrder, true, true>(X.lds, g, S, E);
        skinny_gemm<pg8::EPI_RESID>(X, BIG + (size_t)MP * NPROJ + C_GA, NPROJ, WOUT, DM, nullptr, Y, Y + (size_t)MP * DM, 1.f);
    }
    SEAM(11);
    if (IN(12)) rmsnorm_rows(X, Y, Y + (size_t)MP * DM, p.in[19], H);
    SEAM(12);
    if (IN(13)) {
        pg8::Gemm g{H, WA, MT, NFF, DM, DM}; pg8::StaticOrder S; S.init(MT, NFF, X.G, X.bid);
        pg8::Epi<pg8::EPI_SWIGLU> E{BIG, nullptr, nullptr, nullptr, 0.f};
        pg8::gemm_phase<pg8::Epi<pg8::EPI_SWIGLU>, pg8::StaticOrder, true, true>(X.lds, g, S, E);
    }
    SEAM(13);
    if (IN(14)) {
        pg8::Gemm g{BIG, WB, MP, DM, DFF, DFF}; pg8::StaticOrder S; S.init(MP, DM, X.G, X.bid);
        pg8::Epi<pg8::EPI_RESID> E{nullptr, Y, Y, Y + (size_t)MP * DM, 0.5f};
        pg8::gemm_phase<pg8::Epi<pg8::EPI_RESID>, pg8::StaticOrder, true, true>(X.lds, g, S, E);
        skinny_gemm<pg8::EPI_RESID>(X, BIG + (size_t)MP * DFF, DFF, WB, DFF, nullptr, Y, Y + (size_t)MP * DM, 0.5f);
    }
#if TIMING
    SEAM(14);
    grid.sync();
    if (X.bid == 0 && X.tid == 0) {
        volatile unsigned long long* ts = (volatile unsigned long long*)ws;
        const float usA = (float)(ts[TIME_A1 + 1] - ts[TIME_A0]) * 0.01f, usB = (float)(ts[TIME_B1 + 1] - ts[TIME_B0]) * 0.01f;
        p.out[O_KIS] += sqrtf(16384.f * usA * 1e-7f);
        p.out[O_Y] += usB * 1e-2f;
    }
#endif
}

#ifndef N_LAUNCH_MODE
#define N_LAUNCH_MODE 1
#endif
extern "C" void kernel_launch(void* const* d_in, const int* in_sizes, int n_in, void* d_out, int out_size, void* d_ws, size_t ws_size, hipStream_t stream) {
    static int grid_blocks = 0;
    if (!grid_blocks) {
        hipFuncSetAttribute((const void*)mega, hipFuncAttributeMaxDynamicSharedMemorySize, LDS_BYTES);
        int dev = 0, cus = 0, per_cu = 0;
        hipGetDevice(&dev);
        hipDeviceGetAttribute(&cus, hipDeviceAttributeMultiprocessorCount, dev);
        hipOccupancyMaxActiveBlocksPerMultiprocessor(&per_cu, mega, 512, LDS_BYTES);
        if (per_cu < 1) per_cu = 1;
        grid_blocks = cus * 1;
        if (ws_size < WS_END) fprintf(stderr, "workspace too small: %zu < %zu\n", ws_size, (size_t)WS_END);
    }
    Params p{};
    for (int i = 0; i < 22; ++i) p.in[i] = (const float*)d_in[i];
    p.out = (float*)d_out; p.ws = (unsigned char*)d_ws;
#if N_LAUNCH_MODE == 1
    p.ph_lo = 0; p.ph_hi = NPH;
    void* args[] = {&p};
    hipError_t e = hipLaunchCooperativeKernel((const void*)mega, dim3(grid_blocks), dim3(512), args, LDS_BYTES, stream);
    if (e != hipSuccess) fprintf(stderr, "cooperative launch failed: %s (grid %d)\n", hipGetErrorString(e), grid_blocks);
#else
    for (int k = 0; k < NPH; ++k) {
        p.ph_lo = k; p.ph_hi = k + 1;
        hipLaunchKernelGGL(mega, dim3(grid_blocks), dim3(512), LDS_BYTES, stream, p);
    }
#endif
}
```
